# Optimizing an MI355X kernel written in HIP

```python
import math
import jax, jax.numpy as jnp
from jax import lax
import numpy as np

D_MODEL = 1024
BATCH = 4
SEQ = 4096
DEPTH = 2

N_MIXERS = 2
N_A_LAYERS = (DEPTH + 1) // 2
N_B_LAYERS = DEPTH // 2
A_INNER = 3 * D_MODEL
A_CHUNK = 128
A_GROUPS = 8
A_GROUP_W = A_INNER // A_GROUPS
B_HEADS = 16
B_HEAD_DIM = 64
B_V_DIM = 64
B_KV_LATENT = 256
B_IDX_HEADS = 8
B_IDX_DIM = 64
B_TOPK_MAX = 256
B_QBLK = 128
B_PROJ = B_HEADS * B_HEAD_DIM + B_KV_LATENT + B_IDX_HEADS * B_IDX_DIM + B_IDX_DIM + B_IDX_HEADS
REL_BUCKETS = 32
REL_MAX_DIST = 128
N_EXPERTS = 16
N_GROUPS = 4
EXPERTS_PER_GROUP = N_EXPERTS // N_GROUPS
TOP_K = 2
D_EXPERT = 3584
MOE_BLOCK = 128
EPS = 1e-6

kernel_name = "hybrid_gmlp_dsa_grouped_moe_adaln"


def rms_norm(x, g):
    xf = x.astype(jnp.float32)
    y = xf * lax.rsqrt(jnp.mean(xf * xf, axis=-1, keepdims=True) + EPS)
    return (y * g.astype(jnp.float32)).astype(x.dtype)


def layer_norm(x, g, b):
    xf = x.astype(jnp.float32)
    mu = jnp.mean(xf, axis=-1, keepdims=True)
    var = jnp.mean(jnp.square(xf - mu), axis=-1, keepdims=True)
    y = (xf - mu) * lax.rsqrt(var + EPS)
    return (y * g.astype(jnp.float32) + b.astype(jnp.float32)).astype(x.dtype)


def t5_bucket(dist):
    n = jnp.maximum(dist, 0)
    exact = REL_BUCKETS // 2
    nf = jnp.maximum(n, 1).astype(jnp.float32)
    large = exact + (jnp.log(nf / exact) / math.log(REL_MAX_DIST / exact)
                     * (REL_BUCKETS - exact)).astype(jnp.int32)
    large = jnp.minimum(large, REL_BUCKETS - 1)
    return jnp.where(n < exact, n, large)


def gmlp_mixer(h, w_in, ln_g, ln_b, w_sp, b_sp, w_out):
    bsz, L, _ = h.shape
    z = jax.nn.gelu(h @ w_in)
    u, v = jnp.split(z, 2, axis=-1)
    v = layer_norm(v, ln_g, ln_b)
    nc = L // A_CHUNK
    v = v.reshape(bsz, nc, A_CHUNK, A_GROUPS, A_GROUP_W)
    causal = jnp.tril(jnp.ones((A_CHUNK, A_CHUNK), dtype=w_sp.dtype))
    ws = w_sp * causal
    fv = jnp.einsum('gts,bnsgc->bntgc', ws, v) + b_sp.T[None, None, :, :, None]
    s = u * fv.reshape(bsz, L, A_INNER)
    return s @ w_out


def dsa_mixer(h, w_in, kv_norm_g, w_uk, w_uv, kidx_g, w_out, rel_bias):
    bsz, L, _ = h.shape
    proj = h @ w_in
    o1 = B_HEADS * B_HEAD_DIM
    o2 = o1 + B_KV_LATENT
    o3 = o2 + B_IDX_HEADS * B_IDX_DIM
    o4 = o3 + B_IDX_DIM
    q, c_kv, q_i, k_i, w_i = jnp.split(proj, [o1, o2, o3, o4], axis=-1)
    q = q.reshape(bsz, L, B_HEADS, B_HEAD_DIM)
    c_kv = rms_norm(c_kv, kv_norm_g)
    q_abs = jnp.einsum('blhd,chd->blhc', q, w_uk) * (B_HEAD_DIM ** -0.5)
    q_i = q_i.reshape(bsz, L, B_IDX_HEADS, B_IDX_DIM)
    k_i = rms_norm(k_i, kidx_g)
    w_i = w_i * (B_IDX_HEADS ** -0.5 * B_IDX_DIM ** -0.5)
    k_top = min(B_TOPK_MAX, L // 4)
    nb = L // B_QBLK
    pos_all = jnp.arange(L, dtype=jnp.int32)

    def to_blocks(a):
        return a.reshape(bsz, nb, B_QBLK, *a.shape[2:]).swapaxes(0, 1)

    def block(args):
        qa, qi, wi, start = args
        t = start + jnp.arange(B_QBLK, dtype=jnp.int32)
        sc = jnp.einsum('bthd,bsd->bths', qi, k_i)
        sc = jnp.einsum('bths,bth->bts', jax.nn.relu(sc), wi).astype(jnp.float32)
        causal = pos_all[None, :] <= t[:, None]
        sc = jnp.where(causal[None], sc, -jnp.inf)
        _, sel = lax.top_k(sc, k_top)
        kv_sel = jax.vmap(lambda cb, ib: cb[ib])(c_kv, sel)
        dist = t[None, :, None] - sel
        valid = dist >= 0
        bias = rel_bias[t5_bucket(dist)]
        logits = (jnp.einsum('bthc,btkc->bthk', qa, kv_sel).astype(jnp.float32)
                  + jnp.transpose(bias, (0, 1, 3, 2)).astype(jnp.float32))
        logits = jnp.where(valid[:, :, None, :], logits, -jnp.inf)
        p = jax.nn.softmax(logits, axis=-1).astype(qa.dtype)
        o_lat = jnp.einsum('bthk,btkc->bthc', p, kv_sel)
        o = jnp.einsum('bthc,chd->bthd', o_lat, w_uv)
        return o.reshape(bsz, B_QBLK, B_HEADS * B_V_DIM)

    starts = jnp.arange(nb, dtype=jnp.int32) * B_QBLK
    o = lax.map(block, (to_blocks(q_abs), to_blocks(q_i), to_blocks(w_i), starts))
    o = o.swapaxes(0, 1).reshape(bsz, L, B_HEADS * B_V_DIM)
    return o @ w_out


def grouped_moe(h, router_w, router_b, w_gate, w_up, w_down):
    bsz, L, D = h.shape
    N = bsz * L
    hf = h.reshape(N, D)
    aff = jax.nn.sigmoid((hf @ router_w).astype(jnp.float32))
    sel = aff + router_b.astype(jnp.float32)
    sel_g = sel.reshape(N, N_GROUPS, EXPERTS_PER_GROUP)
    grp_score = lax.top_k(sel_g, 2)[0].sum(-1)
    grp = jnp.argmax(grp_score, axis=-1).astype(jnp.int32)
    in_grp = jnp.take_along_axis(sel_g, grp[:, None, None], axis=1)[:, 0]
    _, local = lax.top_k(in_grp, TOP_K)
    experts = grp[:, None] * EXPERTS_PER_GROUP + local
    gates = jnp.take_along_axis(aff, experts, axis=1)
    gates = gates / jnp.sum(gates, axis=-1, keepdims=True)

    A = N * TOP_K
    e_flat = experts.reshape(A)
    order = jnp.argsort(e_flat)
    e_sorted = e_flat[order]
    counts = jnp.bincount(e_flat, length=N_EXPERTS)
    padded = ((counts + MOE_BLOCK - 1) // MOE_BLOCK) * MOE_BLOCK
    pad_end = jnp.cumsum(padded)
    pad_start = pad_end - padded
    seg_start = jnp.cumsum(counts) - counts
    rank = jnp.arange(A, dtype=jnp.int32) - seg_start[e_sorted]
    slot_sorted = (pad_start[e_sorted] + rank).astype(jnp.int32)
    P = A + N_EXPERTS * MOE_BLOCK
    n_blk = P // MOE_BLOCK
    tok_of_slot = jnp.zeros((P,), jnp.int32).at[slot_sorted].set((order // TOP_K).astype(jnp.int32))
    blk_start = jnp.arange(n_blk, dtype=jnp.int32) * MOE_BLOCK
    blk_expert = jnp.minimum(jnp.searchsorted(pad_end, blk_start, side='right'),
                             N_EXPERTS - 1).astype(jnp.int32)
    x_blk = hf[tok_of_slot].reshape(n_blk, MOE_BLOCK, D)

    def expert_block(args):
        xb, e = args
        return (jax.nn.silu(xb @ w_gate[e]) * (xb @ w_up[e])) @ w_down[e]

    y_slot = lax.map(expert_block, (x_blk, blk_expert)).reshape(P, D)
    slot_of_assign = jnp.zeros((A,), jnp.int32).at[order].set(slot_sorted)
    y = y_slot[slot_of_assign].reshape(N, TOP_K, D)
    out = jnp.einsum('nk,nkd->nd', gates.astype(y.dtype), y)
    return out.reshape(bsz, L, D)


def setup_inputs(seed: int = 0) -> dict:
    key = jax.random.key(seed)
    ks = jax.random.split(key, 32)
    f32 = jnp.float32
    D = D_MODEL

    def nrm(k, shape, scale):
        return jax.random.normal(k, shape, f32) * scale

    return {
        "x": nrm(ks[0], (BATCH, SEQ, D), 1.0),
        "c": nrm(ks[1], (BATCH, D), 1.0),
        "ada_w": nrm(ks[2], (DEPTH, D, 6 * D), 0.5 * D ** -0.5),
        "ada_b": nrm(ks[3], (DEPTH, 6 * D), 0.02),
        "norm1_g": 1.0 + nrm(ks[4], (DEPTH, D), 0.05),
        "norm2_g": 1.0 + nrm(ks[5], (DEPTH, D), 0.05),
        "a_w_in": nrm(ks[6], (N_A_LAYERS, D, 2 * A_INNER), D ** -0.5),
        "a_ln_g": 1.0 + nrm(ks[7], (N_A_LAYERS, A_INNER), 0.05),
        "a_ln_b": nrm(ks[8], (N_A_LAYERS, A_INNER), 0.02),
        "a_w_sp": nrm(ks[9], (N_A_LAYERS, A_GROUPS, A_CHUNK, A_CHUNK), A_CHUNK ** -0.5),
        "a_b_sp": 1.0 + nrm(ks[10], (N_A_LAYERS, A_GROUPS, A_CHUNK), 0.1),
        "a_w_out": nrm(ks[11], (N_A_LAYERS, A_INNER, D), A_INNER ** -0.5),
        "b_w_in": nrm(ks[12], (N_B_LAYERS, D, B_PROJ), D ** -0.5),
        "b_kv_norm_g": 1.0 + nrm(ks[13], (N_B_LAYERS, B_KV_LATENT), 0.05),
        "b_w_uk": nrm(ks[14], (N_B_LAYERS, B_KV_LATENT, B_HEADS, B_HEAD_DIM), B_KV_LATENT ** -0.5),
        "b_w_uv": nrm(ks[15], (N_B_LAYERS, B_KV_LATENT, B_HEADS, B_V_DIM), B_KV_LATENT ** -0.5),
        "b_kidx_g": 1.0 + nrm(ks[16], (N_B_LAYERS, B_IDX_DIM), 0.05),
        "b_w_out": nrm(ks[17], (N_B_LAYERS, B_HEADS * B_V_DIM, D), (B_HEADS * B_V_DIM) ** -0.5),
        "rel_bias": nrm(ks[18], (REL_BUCKETS, B_HEADS), 0.3),
        "router_w": nrm(ks[19], (D, N_EXPERTS), D ** -0.5),
        "router_b": nrm(ks[20], (N_EXPERTS,), 0.01),
        "moe_w_gate": nrm(ks[21], (DEPTH, N_EXPERTS, D, D_EXPERT), D ** -0.5),
        "moe_w_up": nrm(ks[22], (DEPTH, N_EXPERTS, D, D_EXPERT), D ** -0.5),
        "moe_w_down": nrm(ks[23], (DEPTH, N_EXPERTS, D_EXPERT, D), D_EXPERT ** -0.5),
        "final_g": 1.0 + nrm(ks[24], (D,), 0.05),
    }


def reference(x, c, ada_w, ada_b, norm1_g, norm2_g, a_w_in, a_ln_g, a_ln_b, a_w_sp, a_b_sp,
              a_w_out, b_w_in, b_kv_norm_g, b_w_uk, b_w_uv, b_kidx_g, b_w_out, rel_bias,
              router_w, router_b, moe_w_gate, moe_w_up, moe_w_down, final_g):
    mod = jnp.einsum('bd,lde->lbe', jax.nn.silu(c), ada_w) + ada_b[:, None, :]
    h = x
    for i in range(DEPTH):
        sh1, sc1, g1, sh2, sc2, g2 = jnp.split(mod[i], 6, axis=-1)
        hn = rms_norm(h, norm1_g[i]) * (1.0 + sc1[:, None, :]) + sh1[:, None, :]
        j = i // N_MIXERS
        if i % N_MIXERS == 0:
            y = gmlp_mixer(hn, a_w_in[j], a_ln_g[j], a_ln_b[j], a_w_sp[j], a_b_sp[j], a_w_out[j])
        else:
            y = dsa_mixer(hn, b_w_in[j], b_kv_norm_g[j], b_w_uk[j], b_w_uv[j], b_kidx_g[j],
                          b_w_out[j], rel_bias)
        h = h + g1[:, None, :] * y
        hn = rms_norm(h, norm2_g[i]) * (1.0 + sc2[:, None, :]) + sh2[:, None, :]
        h = h + g2[:, None, :] * grouped_moe(hn, router_w, router_b, moe_w_gate[i],
                                             moe_w_up[i], moe_w_down[i])
    return rms_norm(h, final_g)
```

```cpp
#include <hip/hip_runtime.h>
#include <cstdio>
#include <cstdint>

#ifndef MK_STAGE
#define MK_STAGE 9
#endif

#define GAS __attribute__((address_space(1)))
#define LAS __attribute__((address_space(3)))
typedef unsigned short bf16;
typedef short bf16x8 __attribute__((ext_vector_type(8)));
typedef short bf16x4 __attribute__((ext_vector_type(4)));
typedef float f32x4 __attribute__((ext_vector_type(4)));
typedef float f32x2 __attribute__((ext_vector_type(2)));
typedef unsigned u32x4 __attribute__((ext_vector_type(4)));
typedef unsigned u32x2 __attribute__((ext_vector_type(2)));
typedef int i32x4 __attribute__((ext_vector_type(4)));
typedef short v4i16_t __attribute__((ext_vector_type(4)));

constexpr int NB_ = 4, SEQ = 4096, D = 1024, M = NB_ * SEQ;
constexpr int AIN = 3072, NZ = 6144, NGRP = 8, GW = 384, CHUNK = 128;
constexpr int NH = 16, HD = 64, CL = 256, HI = 8, DI = 64, KTOP = 256;
constexpr int BPROJ = 1864, NPROJ = 2048;
constexpr int O_CKV = 1024, O_QI = 1280, O_KI = 1792, O_WI = 1856;
constexpr int NE = 16, DE = 3584, NGU = 7168;
constexpr int PMAX = 2 * M + NE * 256;
constexpr float EPS = 1e-6f;

constexpr size_t MiB = 1u << 20;
constexpr size_t WS_CTL = 0, CTL_ZERO_BYTES = 1 * MiB;
constexpr size_t WS_WINA = 2 * MiB, WS_WOUTA = 14 * MiB, WS_WINB = 20 * MiB, WS_WOUTB = 24 * MiB;
constexpr size_t WS_WUK = 26 * MiB, WS_WUVT = 26 * MiB + 512 * 1024, WS_WSP = 27 * MiB;
constexpr size_t WS_MODP = 28 * MiB, WS_MODF = 30 * MiB, WS_TOKINFO = 31 * MiB, WS_LIST = 31 * MiB + 512 * 1024;
constexpr size_t WS_HIST = 32 * MiB + 512 * 1024;
constexpr size_t WS_VSTAT = 33 * MiB, WS_HN = 40 * MiB, WS_HA = 72 * MiB, WS_HB = 136 * MiB;
constexpr size_t WS_WGU = 200 * MiB, WS_WD = 648 * MiB, WS_BIG = 872 * MiB;
constexpr size_t WS_U = WS_BIG, WS_V = WS_BIG + 96 * MiB, WS_S = WS_BIG + 192 * MiB;
constexpr size_t WS_HMOE = WS_BIG, WS_YSLOT = WS_BIG + 256 * MiB, WS_SLAB = WS_BIG + 400 * MiB;
constexpr size_t WS_PROJ = WS_BIG, WS_OLAT = WS_BIG, WS_QABS = WS_BIG + 128 * MiB, WS_SC = WS_BIG + 256 * MiB;
constexpr size_t WS_SEL = WS_BIG + 512 * MiB, WS_CKV = WS_BIG + 528 * MiB, WS_QI = WS_BIG + 536 * MiB, WS_KI = WS_BIG + 552 * MiB;
constexpr size_t WS_WI = WS_BIG + 554 * MiB, WS_O = WS_BIG + 556 * MiB, WS_END = WS_BIG + 588 * MiB;
static_assert((size_t)PMAX * DE * 2 <= 256 * MiB && (size_t)PMAX * D * 4 <= 144 * MiB, "moe buffers");
constexpr int CW_TMO = 0, CW_BAR = 4096, CW_CNT = 8192;

constexpr int RING_BYTES = 131072, MISC_OFF = 140 * 1024, LDS_BYTES = 163840;
constexpr int TAB_OFF = RING_BYTES;
constexpr int NWAVES = 8, NTHR = 512;

#define LDS_WAIT() asm volatile("s_waitcnt lgkmcnt(0)" ::: "memory")
#define VM_WAIT() asm volatile("s_waitcnt vmcnt(0)" ::: "memory")

typedef __bf16 bf16x2_t __attribute__((ext_vector_type(2)));
__device__ __forceinline__ unsigned cvt_pk_bf16(float lo, float hi) { const f32x2 v = {lo, hi}; const bf16x2_t b = __builtin_convertvector(v, bf16x2_t); return __builtin_bit_cast(unsigned, b); }
__device__ __forceinline__ float bf2f(unsigned short b) { return __builtin_bit_cast(float, ((unsigned)b) << 16); }
__device__ __forceinline__ float bflo(unsigned w) { return __builtin_bit_cast(float, w << 16); }
__device__ __forceinline__ float bfhi(unsigned w) { return __builtin_bit_cast(float, w & 0xffff0000u); }
__device__ __forceinline__ float wave_sum(float v) {
#pragma unroll
    for (int o = 1; o < 64; o <<= 1) v += __shfl_xor(v, o);
    return v;
}
__device__ __forceinline__ float fast_exp(float x) { return __builtin_amdgcn_exp2f(x * 1.44269504089f); }
__device__ __forceinline__ float sigmoidf_(float x) { return __builtin_amdgcn_rcpf(1.0f + fast_exp(-x)); }

#define XB_TMO      128
#define XB_XCNT(j)  (256  + 64 * (j))
#define XB_XSUB(j)  (1280 + 64 * (j))
#define XB_XGEN(j)  (2304 + 64 * (j))
#define XB_TOP      3328
#define XB_TOPGEN   3392
#define XCD_BAR_WORDS 3456
#define XB_SPIN_CAP (1u << 18)
__device__ __forceinline__ unsigned xb_ld(unsigned* p)              { return __hip_atomic_load(p, __ATOMIC_RELAXED, __HIP_MEMORY_SCOPE_AGENT); }
__device__ __forceinline__ unsigned xb_add(unsigned* p, unsigned v) { return __hip_atomic_fetch_add(p, v, __ATOMIC_RELAXED, __HIP_MEMORY_SCOPE_AGENT); }
__device__ __forceinline__ unsigned xb_xcc_id() { return (unsigned)__builtin_amdgcn_s_getreg((3 << 11) | 20) & 0xFu; }
#define XB_SPIN(cond, bar) do { unsigned _sp = 0; while (cond) { __builtin_amdgcn_s_sleep(1); \
    if ((++_sp & 255u) == 0u) { if (xb_ld(&(bar)[XB_TMO])) break; if (_sp > XB_SPIN_CAP) { atomicAdd(&(bar)[XB_TMO], 1u); break; } } } } while (0)
struct XcdBarrier { unsigned* bar; unsigned x; volatile LAS unsigned* st; };
__device__ __forceinline__ XcdBarrier xcd_barrier_post(unsigned* bar, volatile LAS unsigned* st) {
    XcdBarrier b; b.bar = bar; b.x = xb_xcc_id(); b.st = st;
    if (threadIdx.x == 0) (void)xb_add(&bar[XB_XCNT(b.x)], 1u);
    return b;
}
__device__ __forceinline__ void xcd_barrier_complete(unsigned* bar, unsigned x, unsigned& nloc, unsigned& nx) {
    const unsigned G = gridDim.x * gridDim.y * gridDim.z;
    unsigned sum, cnt, mine, sp = 0u;
    for (;;) {
        sum = 0u; cnt = 0u; mine = 0u;
#pragma unroll
        for (unsigned j = 0; j < 16; ++j) { const unsigned c = xb_ld(&bar[XB_XCNT(j)]); sum += c; cnt += (c > 0u) ? 1u : 0u; mine = (j == x) ? c : mine; }
        if (sum == G) break;
        __builtin_amdgcn_s_sleep(1);
        if ((++sp & 255u) == 0u) { if (xb_ld(&bar[XB_TMO])) break; if (sp > XB_SPIN_CAP) { atomicAdd(&bar[XB_TMO], 1u); break; } }
    }
    nloc = mine > 0u ? mine : 1u; nx = cnt > 0u ? cnt : 1u;
}
__device__ __forceinline__ void xcd_barrier(const XcdBarrier& b) {
    asm volatile("s_waitcnt vmcnt(0)" ::: "memory");
    __syncthreads();
    if (threadIdx.x == 0) {
        unsigned* bar = b.bar;
        __builtin_amdgcn_s_waitcnt(0);
        unsigned nloc = b.st[0], nx = b.st[1];
        if (nloc == 0u) { xcd_barrier_complete(bar, b.x, nloc, nx); b.st[0] = nloc; b.st[1] = nx; }
        const unsigned old = xb_add(&bar[XB_XSUB(b.x)], 1u);
        const unsigned gen = old / nloc;
        if (old + 1u == (gen + 1u) * nloc) {
            __builtin_amdgcn_fence(__ATOMIC_RELEASE, "agent");
            asm volatile("s_waitcnt vmcnt(0)" ::: "memory");
            const unsigned og = xb_add(&bar[XB_TOP], 1u);
            const unsigned tg = og / nx;
            if (og + 1u == (tg + 1u) * nx) xb_add(&bar[XB_TOPGEN], 1u);
            else XB_SPIN(xb_ld(&bar[XB_TOPGEN]) == tg, bar);
            __builtin_amdgcn_fence(__ATOMIC_ACQUIRE, "agent");
            xb_add(&bar[XB_XGEN(b.x)], 1u);
            asm volatile("s_waitcnt vmcnt(0)" ::: "memory");
        } else {
            XB_SPIN(xb_ld(&bar[XB_XGEN(b.x)]) == gen, bar);
            __builtin_amdgcn_fence(__ATOMIC_ACQUIRE, "agent");
            asm volatile("s_waitcnt vmcnt(0)" ::: "memory");
        }
    }
    __syncthreads();
}

namespace pg8 {
constexpr int BM = 256, BK = 64, HALF = 128, HTB = HALF * BK * 2, STAGE_BYTES = 8 * HTB, NXCD = 8, WGM = 8;
__device__ __forceinline__ int lds_byte(int r, int c) { const int st = (r >> 4) * 2 + (c >> 5), rr = r & 15, cc = c & 31, ob = rr * 64 + cc * 2; return st * 1024 + (ob ^ (((ob >> 9) & 1) << 5)); }
__device__ __forceinline__ void stage_rc(int b, int& R, int& C) { const int st = b / 1024, sb = b % 1024, swz = sb ^ (((sb >> 9) & 1) << 5); R = (st >> 1) * 16 + swz / 64; C = (st & 1) * 32 + (swz % 64) / 2; }
__device__ __forceinline__ int perm32(int rho) { const int n = rho >> 4, i = rho & 15; return 8 * (i >> 2) + 4 * n + (i & 3); }
__device__ __forceinline__ int xcd_remap(int wgid, int nwg) { const int q = nwg / NXCD, r = nwg % NXCD, xcd = wgid % NXCD, off = wgid / NXCD; return (xcd < r ? xcd * (q + 1) : r * (q + 1) + (xcd - r) * q) + off; }

struct Unit { int pm, pn, e, hrow, nvalid, lbase, kt0, nt, slab; };

struct DenseSched {
    const bf16* A; const bf16* Bt; int K, nM, nN, nwg, G, c;
    __device__ void init(const bf16* A_, const bf16* Bt_, int M_, int N_, int K_, int G_, int c_) { A = A_; Bt = Bt_; K = K_; nM = M_ / BM; nN = N_ / BM; nwg = nM * nN; G = G_; c = c_; }
    __device__ __forceinline__ bool next(int i, Unit& u) const {
        const long L = (long)i * G + c; if (L >= nwg) return false;
        const int wgid = xcd_remap((int)L, nwg);
        const int nig = WGM * nN, gid = wgid / nig, fm = gid * WGM, gsz = (nM - fm) < WGM ? (nM - fm) : WGM;
        u.pm = fm + ((wgid % nig) % gsz); u.pn = (wgid % nig) / gsz; u.e = 0; u.hrow = u.pm * BM; u.nvalid = BM; u.lbase = 0; u.kt0 = 0; u.nt = K / BK; u.slab = -1; return true;
    }
    __device__ __forceinline__ const char* a_base(const Unit& u) const { return (const char*)A + (size_t)u.pm * BM * K * 2; }
    __device__ __forceinline__ const char* b_base(const Unit& u) const { return (const char*)Bt + (size_t)u.pn * BM * K * 2; }
    __device__ __forceinline__ bool late() const { return false; }
    __device__ __forceinline__ void prefetch(const Unit&, int, int) const {}
    __device__ __forceinline__ void a_voff_late(const Unit&, const int (&)[2], const int (&)[2], unsigned (&)[2][2], int) const {}
    __device__ __forceinline__ void a_voff(const Unit&, const int (&R)[2], const int (&C)[2], unsigned (&v)[2][2]) const {
#pragma unroll
        for (int h = 0; h < 2; ++h)
#pragma unroll
            for (int i = 0; i < 2; ++i) v[h][i] = (unsigned)((h * HALF + R[i]) * K + C[i]) * 2u;
    }
};
struct MoeSched {
    const bf16* A; const bf16* Bt; const unsigned* list; const volatile LAS int* tab; int K, ncol, G, c; bool gather; size_t bstride;
    LAS unsigned* lbuf;
    bool ksplit;
    __device__ __forceinline__ int T(int i) const { return __builtin_amdgcn_readfirstlane(tab[i]); }
    __device__ __forceinline__ bool split_on(int nwg) const { return ksplit && G == 256 && nwg > 2 * G && nwg - 2 * G <= G / 4 && ((K / BK) % 8) == 0; }
    __device__ __forceinline__ void decode(int wgid, Unit& u) const {
        int e = 0;
#pragma unroll
        for (int j = 1; j < 16; ++j) e += (wgid >= T(j)) ? 1 : 0;
        const int local = wgid - T(e), tiles = T(17 + e);
        const int pn = local / tiles, rt = local % tiles;
        u.e = e; u.pn = pn; u.pm = rt; u.hrow = T(33 + e) + rt * BM; const int rem = T(49 + e) - rt * BM; u.nvalid = rem < BM ? rem : BM; u.lbase = rt * BM;
    }
    __device__ __forceinline__ bool next(int i, Unit& u) const {
        const int nwg = T(65); const int ntf = K / BK;
        int wgid, kt0 = 0, ntu = ntf, slab = -1;
        if (split_on(nwg)) {
            if (i > 2) return false;
            if (i < 2) wgid = xcd_remap(i * G + c, 2 * G);
            else { wgid = 2 * G + (c >> 2); if (wgid >= nwg) return false; ntu = ntf / 4; kt0 = (c & 3) * ntu; slab = c; }
        } else { const long L = (long)i * G + c; if (L >= nwg) return false; wgid = xcd_remap((int)L, nwg); }
        decode(wgid, u); u.kt0 = kt0; u.nt = ntu; u.slab = slab; return true;
    }
    __device__ __forceinline__ const char* a_base(const Unit& u) const { return (gather ? (const char*)A : (const char*)A + (size_t)u.hrow * K * 2) + (size_t)u.kt0 * (BK * 2); }
    __device__ __forceinline__ const char* b_base(const Unit& u) const { return (const char*)Bt + (size_t)u.e * bstride + (size_t)u.pn * BM * K * 2 + (size_t)u.kt0 * (BK * 2); }
    __device__ __forceinline__ bool late() const { return gather; }
    __device__ __forceinline__ void prefetch(const Unit& u, int slot, int lane) const {
        if (gather) __builtin_amdgcn_global_load_lds((const unsigned*)(list + (size_t)u.e * M + u.lbase + 4 * lane), (LAS unsigned*)(lbuf + slot * 256), 16, 0, 0); }
    __device__ __forceinline__ void a_voff_late(const Unit& u, const int (&R)[2], const int (&C)[2], unsigned (&v)[2][2], int slot) const {
#pragma unroll
        for (int h = 0; h < 2; ++h)
#pragma unroll
            for (int i = 0; i < 2; ++i) { const int r = h * HALF + R[i]; unsigned tok = lbuf[slot * 256 + r]; tok = r < u.nvalid ? tok : 0u; v[h][i] = (tok * (unsigned)K + (unsigned)C[i]) * 2u; } }
    __device__ __forceinline__ void a_voff(const Unit& u, const int (&R)[2], const int (&C)[2], unsigned (&v)[2][2]) const {
#pragma unroll
        for (int h = 0; h < 2; ++h)
#pragma unroll
            for (int i = 0; i < 2; ++i) {
                const int r = h * HALF + R[i];
                if (gather) { const int rc = r < u.nvalid ? r : u.nvalid - 1; unsigned tok = list[(size_t)u.e * M + u.lbase + rc]; tok = r < u.nvalid ? tok : 0u; v[h][i] = (tok * (unsigned)K + (unsigned)C[i]) * 2u; }
                else v[h][i] = (unsigned)(r * K + C[i]) * 2u;
            }
    }
};

template <class Epi, class Sched>
__device__ __forceinline__ void gemm_phase(LAS unsigned char* lds, const Sched& S, const Epi& E) {
    const int tid = threadIdx.x, wid = __builtin_amdgcn_readfirstlane(tid >> 6), lane = tid & 63, wr = wid >> 2, wc = wid & 3, fr = lane & 15, fq = lane >> 4;
    const int K = S.K; int nt = K / BK;
    int Rr[2], Cc[2]; unsigned voffB[2];
#pragma unroll
    for (int i = 0; i < 2; ++i) { int R, C; stage_rc(tid * 16 + i * 8192, R, C); Rr[i] = R; Cc[i] = C; const int Rb = Epi::PERM ? ((R & ~31) + perm32(R & 31)) : R; voffB[i] = (unsigned)(Rb * K + C) * 2u; }
    const size_t kstep = (size_t)(BK * 2);
    const size_t hstep = (size_t)HALF * K * 2;
    const unsigned ldsw = (unsigned)wid * 1024u;
    const int aoff = lds_byte(wr * 64 + fr, fq * 8), boff = lds_byte(wc * 32 + fr, fq * 8);
#define PG8_SA(b, h) (((b) * 2 + (h)) * HTB)
#define PG8_SB(b, h) ((4 + (b) * 2 + (h)) * HTB)
#define PG8_STAGE(bufoff, gbase, voff) do { _Pragma("unroll") for (int _i = 0; _i < 2; ++_i) \
        __builtin_amdgcn_global_load_lds((const unsigned*)((const char*)(gbase) + (voff)[_i]), (LAS unsigned*)(lds + (bufoff) + ldsw + _i * 8192), 16, 0, 0); } while (0)
#define PG8_LDA(dst, b, h) do { _Pragma("unroll") for (int m = 0; m < 4; ++m) _Pragma("unroll") for (int k = 0; k < 2; ++k) dst[m][k] = *(const LAS bf16x8*)(lds + PG8_SA(b, h) + aoff + m * 2048 + k * 1024); } while (0)
#define PG8_LDB(dst, b, h) do { _Pragma("unroll") for (int n = 0; n < 2; ++n) _Pragma("unroll") for (int k = 0; k < 2; ++k) dst[n][k] = *(const LAS bf16x8*)(lds + PG8_SB(b, h) + boff + n * 2048 + k * 1024); } while (0)
#define PG8_MMA(ai, bj, At, Bt) do { __builtin_amdgcn_s_setprio(1); _Pragma("unroll") for (int m = 0; m < 4; ++m) _Pragma("unroll") for (int n = 0; n < 2; ++n) _Pragma("unroll") for (int k = 0; k < 2; ++k) \
        acc[ai][bj][m][n] = __builtin_amdgcn_mfma_f32_16x16x32_bf16(Bt[n][k], At[m][k], acc[ai][bj][m][n], 0, 0, 0); __builtin_amdgcn_s_setprio(0); } while (0)
#define PG8_WAIT_V(n) asm volatile("s_waitcnt vmcnt(" #n ")" ::: "memory")
#define PG8_WAIT_L(n) asm volatile("s_waitcnt lgkmcnt(" #n ")" ::: "memory")
#define PG8_BAR __builtin_amdgcn_s_barrier()
#define PG8_SCHED __builtin_amdgcn_sched_barrier(0)
    Unit cur, nxt; int ui = 0;
    if (!S.next(0, cur)) return;
    f32x4 acc[2][2][4][2];
#pragma unroll
    for (int a = 0; a < 2; ++a)
#pragma unroll
        for (int b = 0; b < 2; ++b)
#pragma unroll
            for (int m = 0; m < 4; ++m)
#pragma unroll
                for (int n = 0; n < 2; ++n) acc[a][b][m][n] = (f32x4){0.f, 0.f, 0.f, 0.f};
    bf16x8 At[4][2], B0[2][2], B1[2][2];
    unsigned vc[2][2], vn[2][2];
    S.a_voff(cur, Rr, Cc, vc); nt = cur.nt;
    const char* cA = S.a_base(cur); const char* cB = S.b_base(cur);
    PG8_STAGE(PG8_SB(0, 0), cB, voffB); PG8_STAGE(PG8_SB(0, 1), cB + hstep, voffB); PG8_STAGE(PG8_SA(0, 0), cA, vc[0]); PG8_STAGE(PG8_SA(0, 1), cA, vc[1]);
    if (wr == 1) PG8_BAR;
    PG8_WAIT_V(2); PG8_BAR;
    PG8_STAGE(PG8_SB(1, 0), cB + kstep, voffB); PG8_STAGE(PG8_SA(1, 0), cA + kstep, vc[0]); PG8_STAGE(PG8_SB(1, 1), cB + hstep + kstep, voffB);
    PG8_WAIT_V(6); PG8_BAR;
    for (;;) {
        const bool has_next = S.next(ui + 1, nxt);
        const char* nA = has_next ? S.a_base(nxt) : cA; const char* nB = has_next ? S.b_base(nxt) : cB;
        if (has_next && S.late()) S.prefetch(nxt, ui & 1, lane);
        else if (has_next) S.a_voff(nxt, Rr, Cc, vn);
        else {
#pragma unroll
            for (int h = 0; h < 2; ++h)
#pragma unroll
                for (int i = 0; i < 2; ++i) vn[h][i] = vc[h][i]; }
        for (int t = 0; t < nt; t += 2) {
            const bool last = (t == nt - 2);
            const char* a1 = cA + (size_t)(t + 1) * kstep;
            const char* a2 = last ? nA : cA + (size_t)(t + 2) * kstep; const char* b2 = last ? nB : cB + (size_t)(t + 2) * kstep;
            const char* a3 = a2 + kstep; const char* b3 = b2 + kstep;
            if (last && has_next && S.late()) S.a_voff_late(nxt, Rr, Cc, vn, ui & 1);
            unsigned vx[2][2];
#pragma unroll
            for (int h = 0; h < 2; ++h)
#pragma unroll
                for (int i = 0; i < 2; ++i) vx[h][i] = last ? vn[h][i] : vc[h][i];
            PG8_LDB(B0, 0, 0); PG8_LDB(B1, 0, 1); PG8_SCHED; PG8_LDA(At, 0, 0); PG8_STAGE(PG8_SA(1, 1), a1, vc[1]);
            PG8_WAIT_V(8); PG8_WAIT_L(0); PG8_BAR; PG8_MMA(0, 0, At, B0); PG8_MMA(0, 1, At, B1); PG8_BAR; PG8_SCHED;
            PG8_LDA(At, 0, 1); PG8_STAGE(PG8_SB(0, 0), b2, voffB); PG8_STAGE(PG8_SB(0, 1), b2 + hstep, voffB); PG8_STAGE(PG8_SA(0, 0), a2, vx[0]);
            PG8_WAIT_V(8); PG8_WAIT_L(0); PG8_BAR; PG8_MMA(1, 0, At, B0); PG8_MMA(1, 1, At, B1); PG8_BAR; PG8_SCHED;
            PG8_LDB(B0, 1, 0); PG8_LDB(B1, 1, 1); PG8_SCHED; PG8_LDA(At, 1, 0); PG8_STAGE(PG8_SA(0, 1), a2, vx[1]);
            PG8_WAIT_V(8); PG8_WAIT_L(0); PG8_BAR; PG8_MMA(0, 0, At, B0); PG8_MMA(0, 1, At, B1); PG8_BAR; PG8_SCHED;
            PG8_LDA(At, 1, 1); PG8_STAGE(PG8_SB(1, 0), b3, voffB); PG8_STAGE(PG8_SB(1, 1), b3 + hstep, voffB); PG8_STAGE(PG8_SA(1, 0), a3, vx[0]);
            PG8_WAIT_V(8); PG8_WAIT_L(0); PG8_BAR; PG8_MMA(1, 0, At, B0); PG8_MMA(1, 1, At, B1); PG8_BAR; PG8_SCHED;
        }
        if (wr == 0) PG8_BAR;
        E(acc, cur, wr, wc, fr, fq);
        if (!has_next) break;
#pragma unroll
        for (int a = 0; a < 2; ++a)
#pragma unroll
            for (int b = 0; b < 2; ++b)
#pragma unroll
                for (int m = 0; m < 4; ++m)
#pragma unroll
                    for (int n = 0; n < 2; ++n) acc[a][b][m][n] = (f32x4){0.f, 0.f, 0.f, 0.f};
        cur = nxt; cA = nA; cB = nB; ++ui; nt = cur.nt;
#pragma unroll
        for (int h = 0; h < 2; ++h)
#pragma unroll
            for (int i = 0; i < 2; ++i) vc[h][i] = vn[h][i];
        if (wr == 1) PG8_BAR;
    }
    PG8_WAIT_V(0);
    PG8_BAR;
#undef PG8_SA
#undef PG8_SB
#undef PG8_STAGE
#undef PG8_LDA
#undef PG8_LDB
#undef PG8_MMA
#undef PG8_WAIT_V
#undef PG8_WAIT_L
#undef PG8_BAR
#undef PG8_SCHED
}

__device__ __forceinline__ float gelu_tanh(float x) { const float y = 1.5957691216f * (x + 0.044715f * x * x * x); return x * __builtin_amdgcn_rcpf(1.0f + __builtin_amdgcn_exp2f(-1.44269504089f * y)); }
struct EpiGeluUV {
    static constexpr bool PERM = true;
    bf16* U; bf16* V; f32x2* vstat;
    __device__ __forceinline__ void operator()(const f32x4 (&acc)[2][2][4][2], const Unit& u, int wr, int wc, int fr, int fq) const {
        const bool isv = u.pn >= 12; const int ct = isv ? u.pn - 12 : u.pn;
        bf16* base = isv ? V : U;
        const int row0 = u.pm * BM + wr * 64 + fr, col0 = ct * BM + wc * 32 + 8 * fq;
#pragma unroll
        for (int ai = 0; ai < 2; ++ai)
#pragma unroll
            for (int m = 0; m < 4; ++m) { const int row = row0 + ai * HALF + m * 16; bf16* rowp = base + (size_t)row * AIN + col0; float s1 = 0.f, s2 = 0.f;
#pragma unroll
                for (int bj = 0; bj < 2; ++bj) { f32x4 v0 = acc[ai][bj][m][0], v1 = acc[ai][bj][m][1];
#pragma unroll
                    for (int j = 0; j < 4; ++j) { v0[j] = gelu_tanh(v0[j]); v1[j] = gelu_tanh(v1[j]); s1 += v0[j] + v1[j]; s2 += v0[j] * v0[j] + v1[j] * v1[j]; }
                    u32x4 w; w.x = cvt_pk_bf16(v0[0], v0[1]); w.y = cvt_pk_bf16(v0[2], v0[3]); w.z = cvt_pk_bf16(v1[0], v1[1]); w.w = cvt_pk_bf16(v1[2], v1[3]);
                    *(u32x4*)(rowp + bj * HALF) = w; }
                if (isv) { s1 += __shfl_xor(s1, 16); s1 += __shfl_xor(s1, 32); s2 += __shfl_xor(s2, 16); s2 += __shfl_xor(s2, 32);
                    if (fq == 0) vstat[(size_t)row * 48 + ct * 4 + wc] = (f32x2){s1, s2}; } }
    }
};
struct EpiResid {
    static constexpr bool PERM = false;
    const float* base; float* out; const float* gate;
    __device__ __forceinline__ void operator()(const f32x4 (&acc)[2][2][4][2], const Unit& u, int wr, int wc, int fr, int fq) const {
        const int row0 = u.pm * BM + wr * 64 + fr, col0 = u.pn * BM + wc * 32 + 4 * fq; const int b = (u.pm * BM) / SEQ;
        f32x4 gv[2][2];
#pragma unroll
        for (int bj = 0; bj < 2; ++bj)
#pragma unroll
            for (int n = 0; n < 2; ++n) gv[bj][n] = *(const f32x4*)(gate + b * 6144 + col0 + bj * HALF + n * 16);
#pragma unroll
        for (int ai = 0; ai < 2; ++ai)
#pragma unroll
            for (int m = 0; m < 4; m += 2) { const size_t off = (size_t)(row0 + ai * HALF + m * 16) * D + col0;
                f32x4 bs[2][2][2];
#pragma unroll
                for (int mm = 0; mm < 2; ++mm)
#pragma unroll
                    for (int bj = 0; bj < 2; ++bj)
#pragma unroll
                        for (int n = 0; n < 2; ++n) bs[mm][bj][n] = *(const f32x4*)(base + off + (size_t)mm * 16 * D + bj * HALF + n * 16);
#pragma unroll
                for (int mm = 0; mm < 2; ++mm)
#pragma unroll
                    for (int bj = 0; bj < 2; ++bj)
#pragma unroll
                        for (int n = 0; n < 2; ++n) *(f32x4*)(out + off + (size_t)mm * 16 * D + bj * HALF + n * 16) = bs[mm][bj][n] + gv[bj][n] * acc[ai][bj][m + mm][n]; }
    }
};
struct EpiF32 {
    static constexpr bool PERM = false;
    float* C; int ldc; float* slabs;
    __device__ __forceinline__ void operator()(const f32x4 (&acc)[2][2][4][2], const Unit& u, int wr, int wc, int fr, int fq) const {
        const bool sp = u.slab >= 0;
        const int row0 = (sp ? 0 : u.hrow) + wr * 64 + fr, col0 = (sp ? 0 : u.pn * BM) + wc * 32 + 4 * fq; const int ld = sp ? BM : ldc;
        float* base = sp ? slabs + (size_t)u.slab * (BM * BM) : C;
#pragma unroll
        for (int ai = 0; ai < 2; ++ai)
#pragma unroll
            for (int m = 0; m < 4; ++m) { float* rowp = base + (size_t)(row0 + ai * HALF + m * 16) * ld + col0;
#pragma unroll
                for (int bj = 0; bj < 2; ++bj)
#pragma unroll
                    for (int n = 0; n < 2; ++n) *(f32x4*)(rowp + bj * HALF + n * 16) = acc[ai][bj][m][n]; }
    }
};
struct EpiSwiGLU {
    static constexpr bool PERM = true;
    bf16* H;
    __device__ __forceinline__ void operator()(const f32x4 (&acc)[2][2][4][2], const Unit& u, int wr, int wc, int fr, int fq) const {
        const int row0 = u.hrow + wr * 64 + fr, col0 = u.pn * HALF + wc * 32 + 8 * fq;
#pragma unroll
        for (int ai = 0; ai < 2; ++ai)
#pragma unroll
            for (int m = 0; m < 4; ++m) { bf16* rowp = H + (size_t)(row0 + ai * HALF + m * 16) * DE + col0;
                f32x4 v0, v1;
#pragma unroll
                for (int j = 0; j < 4; ++j) { const float g0 = acc[ai][0][m][0][j], g1 = acc[ai][0][m][1][j];
                    v0[j] = g0 * sigmoidf_(g0) * acc[ai][1][m][0][j]; v1[j] = g1 * sigmoidf_(g1) * acc[ai][1][m][1][j]; }
                u32x4 w; w.x = cvt_pk_bf16(v0[0], v0[1]); w.y = cvt_pk_bf16(v0[2], v0[3]); w.z = cvt_pk_bf16(v1[0], v1[1]); w.w = cvt_pk_bf16(v1[2], v1[3]);
                *(u32x4*)rowp = w; }
    }
};
struct EpiYbf {
    static constexpr bool PERM = true;
    bf16* Y; bf16* slabs;
    __device__ __forceinline__ void operator()(const f32x4 (&acc)[2][2][4][2], const Unit& u, int wr, int wc, int fr, int fq) const {
        const bool sp = u.slab >= 0;
        bf16* base = sp ? slabs + (size_t)u.slab * (BM * BM) : Y + (size_t)u.hrow * D + u.pn * BM;
        const int ld = sp ? BM : D;
        base += (size_t)(wr * 64 + fr) * ld + wc * 32 + 8 * fq;
#pragma unroll
        for (int ai = 0; ai < 2; ++ai)
#pragma unroll
            for (int m = 0; m < 4; ++m) { bf16* rowp = base + (size_t)(ai * HALF + m * 16) * ld;
#pragma unroll
                for (int bj = 0; bj < 2; ++bj) { const f32x4 v0 = acc[ai][bj][m][0], v1 = acc[ai][bj][m][1];
                    *(u32x4*)(rowp + bj * HALF) = (u32x4){cvt_pk_bf16(v0[0], v0[1]), cvt_pk_bf16(v0[2], v0[3]), cvt_pk_bf16(v1[0], v1[1]), cvt_pk_bf16(v1[2], v1[3])}; } }
    }
};
}

struct Args { const float* in[25]; float* out; unsigned char* ws; int ph_lo, ph_hi; };
enum { I_X = 0, I_C, I_ADAW, I_ADAB, I_N1G, I_N2G, I_AWIN, I_ALNG, I_ALNB, I_AWSP, I_ABSP, I_AWOUT, I_BWIN, I_BKVG, I_BWUK, I_BWUV, I_BKIG, I_BWOUT, I_RELB, I_RW, I_RB, I_WG, I_WU, I_WDN, I_FG };

__device__ __forceinline__ unsigned f2bf(float f) { unsigned u = __builtin_bit_cast(unsigned, f); return (u + 0x7fffu + ((u >> 16) & 1u)) >> 16; }
__device__ __forceinline__ unsigned pk2(float lo, float hi) { return f2bf(lo) | (f2bf(hi) << 16); }
template <bool NT = false, class DRow>
__device__ __forceinline__ void transpose_item(const float* W, int K, int N, bf16* WT, LAS float* scr, int item, int nblk, int lane, DRow drow) {
    const int kb = item / nblk, nb = item % nblk, k0 = 64 * kb, n0 = 32 * nb;
    const int nn = n0 + (lane & 31); const bool ok = nn < N;
    if constexpr (NT) {
#pragma unroll 8
    for (int i = 0; i < 32; ++i) { const int kk = 2 * i + (lane >> 5); scr[kk * 33 + (lane & 31)] = ok ? (NT ? __builtin_nontemporal_load(W + (size_t)(k0 + kk) * N + nn) : W[(size_t)(k0 + kk) * N + nn]) : 0.f; }
    } else {
#pragma unroll
    for (int i = 0; i < 32; ++i) { const int kk = 2 * i + (lane >> 5); scr[kk * 33 + (lane & 31)] = ok ? (NT ? __builtin_nontemporal_load(W + (size_t)(k0 + kk) * N + nn) : W[(size_t)(k0 + kk) * N + nn]) : 0.f; }
    }
    LDS_WAIT(); asm volatile("" ::: "memory");
    const int c = lane & 7;
#pragma unroll
    for (int j = 0; j < 4; ++j) { const int n = (lane >> 3) + 8 * j; const LAS float* s = scr + (8 * c) * 33 + n;
        u32x4 o; o.x = pk2(s[0 * 33], s[1 * 33]); o.y = pk2(s[2 * 33], s[3 * 33]); o.z = pk2(s[4 * 33], s[5 * 33]); o.w = pk2(s[6 * 33], s[7 * 33]);
        if (NT) __builtin_nontemporal_store(o, (GAS u32x4*)(WT + (size_t)drow(n0 + n) * K + k0 + 8 * c)); else *(GAS u32x4*)(WT + (size_t)drow(n0 + n) * K + k0 + 8 * c) = o; }
    LDS_WAIT(); asm volatile("" ::: "memory");
}
template <bool NT>
__device__ __forceinline__ void moe_transpose(const Args& a, LAS float* scr, int idx, int layer, int lane) {
    unsigned char* ws = a.ws; const int mat = idx / 1792, item = idx % 1792, which = mat >> 4, le = layer * 16 + (mat & 15);
    if (which == 0) transpose_item<NT>(a.in[I_WG] + (size_t)le * D * DE, D, DE, (bf16*)(ws + WS_WGU) + (size_t)le * NGU * D, scr, item, DE / 32, lane, [](int n) { return (n >> 7) * 256 + (n & 127); });
    else if (which == 1) transpose_item<NT>(a.in[I_WU] + (size_t)le * D * DE, D, DE, (bf16*)(ws + WS_WGU) + (size_t)le * NGU * D, scr, item, DE / 32, lane, [](int n) { return (n >> 7) * 256 + 128 + (n & 127); });
    else transpose_item<NT>(a.in[I_WDN] + (size_t)le * DE * D, DE, D, (bf16*)(ws + WS_WD) + (size_t)le * D * DE, scr, item, D / 32, lane, [](int n) { return n; });
}
__device__ __forceinline__ void p0_prologue(const Args& a, LAS unsigned char* lds, int gw, int NGW, int wave, int lane) {
    unsigned char* ws = a.ws;
    LAS float* scr = (LAS float*)(lds + wave * 16384);
    for (int it = gw; it < 2 * 96 * 8; it += NGW) {
        const int ks = it & 7, cc = (it >> 3) % 96, l = it / 768, k0 = ks * 128, col = cc * 64 + lane;
#pragma unroll
        for (int b = 0; b < 4; ++b)
#pragma unroll
            for (int j = 0; j < 2; ++j) { const float v = a.in[I_C][b * D + k0 + j * 64 + lane]; scr[b * 128 + j * 64 + lane] = v * sigmoidf_(v); }
        LDS_WAIT(); asm volatile("" ::: "memory");
        const float* W = a.in[I_ADAW] + ((size_t)l * D + k0) * 6144 + col;
        float a0 = 0.f, a1 = 0.f, a2 = 0.f, a3 = 0.f;
#pragma unroll
        for (int h = 0; h < 2; ++h) {
            float wv[64];
#pragma unroll
            for (int k = 0; k < 64; ++k) wv[k] = W[(size_t)(h * 64 + k) * 6144];
            __builtin_amdgcn_sched_barrier(0);
#pragma unroll
            for (int k = 0; k < 64; ++k) { const int kk = h * 64 + k; const float w = wv[k]; a0 += scr[kk] * w; a1 += scr[128 + kk] * w; a2 += scr[256 + kk] * w; a3 += scr[384 + kk] * w; }
            __builtin_amdgcn_sched_barrier(0);
        }
        float* mp = (float*)(ws + WS_MODP) + (size_t)ks * 49152 + (size_t)l * 24576 + col;
        mp[0] = a0; mp[6144] = a1; mp[2 * 6144] = a2; mp[3 * 6144] = a3;
        LDS_WAIT(); asm volatile("" ::: "memory");
    }
    {
        const int gt = gw * 64 + lane, NT = NGW * 64;
        bf16* wuk = (bf16*)(ws + WS_WUK); bf16* wuvt = (bf16*)(ws + WS_WUVT); bf16* wsp = (bf16*)(ws + WS_WSP);
        for (int i = gt; i < CL * NH * HD; i += NT) wuk[i] = (bf16)f2bf(a.in[I_BWUK][i]);
        for (int i = gt; i < CL * NH * HD; i += NT) { const int c = i & 255, d = (i >> 8) & 63, h = i >> 14; wuvt[i] = (bf16)f2bf(a.in[I_BWUV][(c * NH + h) * HD + d]); }
        for (int i = gt; i < NGRP * CHUNK * CHUNK; i += NT) { const int s = i & 127, t = (i >> 7) & 127; wsp[i] = (s <= t) ? (bf16)f2bf(a.in[I_AWSP][i]) : (bf16)0; }
    }
    constexpr int I_A1 = 16 * 192, I_A2 = 48 * 32, I_B1 = 16 * 64, I_B2 = 16 * 32, I_M = 1792;
    constexpr int NSMALL = I_A1 + I_A2 + I_B1 + I_B2;
    const int NITEMS = NSMALL;
    for (int it = gw; it < NITEMS; it += NGW) {
        int r = it;
        if (r < I_A1) { transpose_item(a.in[I_AWIN], D, NZ, (bf16*)(ws + WS_WINA), scr, r, NZ / 32, lane, [](int n) { return n; }); continue; } r -= I_A1;
        if (r < I_A2) { transpose_item(a.in[I_AWOUT], AIN, D, (bf16*)(ws + WS_WOUTA), scr, r, D / 32, lane, [](int n) { return n; }); continue; } r -= I_A2;
        if (r < I_B1) { transpose_item(a.in[I_BWIN], D, BPROJ, (bf16*)(ws + WS_WINB), scr, r, NPROJ / 32, lane, [](int n) { return n; }); continue; } r -= I_B1;
        if (r < I_B2) { transpose_item(a.in[I_BWOUT], D, D, (bf16*)(ws + WS_WOUTB), scr, r, D / 32, lane, [](int n) { return n; }); continue; } r -= I_B2;
        moe_transpose<false>(a, scr, r, 0, lane);
    }
}

__device__ __forceinline__ float mod_val(const Args& a, bool partials, int l, int b, int j) {
    if (!partials) return ((const float*)(a.ws + WS_MODF))[(l * 4 + b) * 6144 + j];
    float s = a.in[I_ADAB][l * 6144 + j]; const float* mp = (const float*)(a.ws + WS_MODP) + (size_t)(l * 4 + b) * 6144 + j;
#pragma unroll
    for (int ks = 0; ks < 8; ++ks) s += mp[(size_t)ks * 49152];
    return s;
}
__device__ __forceinline__ void load_norm_vecs(const Args& a, bool partials, int l, int b, int shift_part, const float* g, LAS float* vsc, LAS float* vsh) {
    for (int d = threadIdx.x; d < D; d += NTHR) { vsc[d] = g[d] * (1.0f + mod_val(a, partials, l, b, (shift_part + 1) * 1024 + d)); vsh[d] = mod_val(a, partials, l, b, shift_part * 1024 + d); }
}
__device__ __forceinline__ void rms_mod_row(f32x4 (&v)[4], const LAS float* vsc, const LAS float* vsh, int lane) {
    float s = 0.f;
#pragma unroll
    for (int j = 0; j < 4; ++j) s += (v[j].x * v[j].x + v[j].y * v[j].y) + (v[j].z * v[j].z + v[j].w * v[j].w);
    const float rstd = 1.0f / sqrtf(wave_sum(s) * (1.0f / D) + EPS);
#pragma unroll
    for (int j = 0; j < 4; ++j) { const f32x4 c = *(const LAS f32x4*)(vsc + 4 * lane + 256 * j), h = *(const LAS f32x4*)(vsh + 4 * lane + 256 * j); v[j] = v[j] * rstd * c + h; }
}
__device__ __forceinline__ void store_row_bf16(const f32x4 (&v)[4], bf16* orow, int lane) {
    GAS u32x2* o8 = (GAS u32x2*)orow + lane;
#pragma unroll
    for (int j = 0; j < 4; ++j) o8[64 * j] = (u32x2){cvt_pk_bf16(v[j].x, v[j].y), cvt_pk_bf16(v[j].z, v[j].w)};
}

__device__ __forceinline__ bf16x4 lds_tr16(const LAS unsigned char* p) { return __builtin_bit_cast(bf16x4, __builtin_amdgcn_ds_read_tr16_b64_v4i16((LAS v4i16_t*)p)); }
constexpr int SG_STRIDE = 800;
struct CvItem { const float* src; bf16* dst; int N, K, n0, radd; bool plain; };
__device__ __forceinline__ CvItem cv_item(const Args& a, int idx, int layer) {
    unsigned char* ws = a.ws; const int mat = idx / 1792, item = idx % 1792, which = mat >> 4, le = layer * 16 + (mat & 15);
    CvItem c;
    if (which == 2) { const int kb = item >> 5, nb = item & 31; c.N = D; c.K = DE; c.n0 = 32 * nb; c.src = a.in[I_WDN] + (size_t)le * DE * D + (size_t)(64 * kb) * D + c.n0; c.dst = (bf16*)(ws + WS_WD) + (size_t)le * D * DE + 64 * kb; c.plain = true; c.radd = 0; }
    else { const int kb = item / 112, nb = item % 112; c.N = DE; c.K = D; c.n0 = 32 * nb; c.src = (which ? a.in[I_WU] : a.in[I_WG]) + (size_t)le * D * DE + (size_t)(64 * kb) * DE + c.n0; c.dst = (bf16*)(ws + WS_WGU) + (size_t)le * NGU * D + 64 * kb; c.plain = false; c.radd = which ? 128 : 0; }
    return c;
}
__device__ __forceinline__ void cv_load(const CvItem& c, int lane, float (&r)[32]) {
#pragma unroll
    for (int i = 0; i < 32; ++i) { const unsigned off = (unsigned)(((2 * i + (lane >> 5)) * c.N + (lane & 31)) * 4); r[i] = __builtin_nontemporal_load((const float*)((const char*)c.src + off)); }
}
__device__ __forceinline__ void cv_finish(const CvItem& c, LAS float* scr, int lane, const float (&r)[32]) {
    unsigned d[16];
#pragma unroll
    for (int m = 0; m < 16; ++m) {
        const auto sw = __builtin_amdgcn_permlane32_swap(__builtin_bit_cast(unsigned, r[m]), __builtin_bit_cast(unsigned, r[16 + m]), false, false);
        d[m] = cvt_pk_bf16(__builtin_bit_cast(float, (unsigned)sw[0]), __builtin_bit_cast(float, (unsigned)sw[1]));
    }
    LAS unsigned char* sb = (LAS unsigned char*)scr;
    LAS u32x4* wp = (LAS u32x4*)(sb + (lane & 31) * 144 + (lane >> 5) * 64);
#pragma unroll
    for (int q = 0; q < 4; ++q) wp[q] = (u32x4){d[4 * q], d[4 * q + 1], d[4 * q + 2], d[4 * q + 3]};
    LDS_WAIT(); asm volatile("" ::: "memory");
    const int c8 = lane & 7;
#pragma unroll
    for (int j = 0; j < 4; ++j) { const int n = (lane >> 3) + 8 * j;
        const u32x4 o = *(const LAS u32x4*)(sb + n * 144 + c8 * 16);
        const int nn = c.n0 + n, dr = c.plain ? nn : (nn >> 7) * 256 + c.radd + (nn & 127);
        __builtin_nontemporal_store(o, (GAS u32x4*)(c.dst + (size_t)dr * c.K + 8 * c8)); }
    LDS_WAIT(); asm volatile("" ::: "memory");
}
__device__ __forceinline__ void cv_batch3(const Args& a, LAS float* scr, int idx0, int stride, int layer, int lane) {
    const int total = 3 * 16 * 1792;
    if (idx0 + 2 * stride < total) {
        const CvItem c0 = cv_item(a, idx0, layer), c1 = cv_item(a, idx0 + stride, layer), c2 = cv_item(a, idx0 + 2 * stride, layer);
        float R0[32], R1[32], R2[32];
        __builtin_amdgcn_sched_barrier(0);
        cv_load(c0, lane, R0); cv_load(c1, lane, R1); cv_load(c2, lane, R2);
        __builtin_amdgcn_sched_barrier(0);
        cv_finish(c0, scr, lane, R0); cv_finish(c1, scr, lane, R1); cv_finish(c2, scr, lane, R2);
    } else {
#pragma unroll 1
        for (int k = 0; k < 3; ++k) { const int idx = idx0 + k * stride; if (idx < total) { const CvItem c0 = cv_item(a, idx, layer); float R0[32]; cv_load(c0, lane, R0); cv_finish(c0, scr, lane, R0); } }
    }
}
__device__ __forceinline__ CvItem cv64_item(const Args& a, int idx, int layer) {
    unsigned char* ws = a.ws; const int mat = idx / 896, item = idx % 896, which = mat >> 4, le = layer * 16 + (mat & 15);
    CvItem c;
    if (which == 2) { const int kb = item >> 4, nb = item & 15; c.N = D; c.K = DE; c.n0 = 64 * nb; c.src = a.in[I_WDN] + (size_t)le * DE * D + (size_t)(64 * kb) * D + c.n0; c.dst = (bf16*)(ws + WS_WD) + (size_t)le * D * DE + 64 * kb; c.plain = true; c.radd = 0; }
    else { const int kb = item / 56, nb = item % 56; c.N = DE; c.K = D; c.n0 = 64 * nb; c.src = (which ? a.in[I_WU] : a.in[I_WG]) + (size_t)le * D * DE + (size_t)(64 * kb) * DE + c.n0; c.dst = (bf16*)(ws + WS_WGU) + (size_t)le * NGU * D + 64 * kb; c.plain = false; c.radd = which ? 128 : 0; }
    return c;
}
__device__ __forceinline__ void cv64_load(const CvItem& c, int lane, float (&r)[64]) {
#pragma unroll
    for (int i = 0; i < 64; ++i) { const unsigned off = (unsigned)((i * c.N + lane) * 4); r[i] = __builtin_nontemporal_load((const float*)((const char*)c.src + off)); }
}
__device__ __forceinline__ void cv64_finish(const CvItem& c, LAS float* scr, int lane, const float (&r)[64]) {
    LAS unsigned char* sb = (LAS unsigned char*)scr;
    LAS u32x4* wp = (LAS u32x4*)(sb + lane * 144);
#pragma unroll
    for (int q = 0; q < 8; ++q) wp[q] = (u32x4){cvt_pk_bf16(r[8 * q], r[8 * q + 1]), cvt_pk_bf16(r[8 * q + 2], r[8 * q + 3]), cvt_pk_bf16(r[8 * q + 4], r[8 * q + 5]), cvt_pk_bf16(r[8 * q + 6], r[8 * q + 7])};
    LDS_WAIT(); asm volatile("" ::: "memory");
    const int c8 = lane & 7;
#pragma unroll
    for (int j = 0; j < 8; ++j) { const int n = (lane >> 3) + 8 * j;
        const u32x4 o = *(const LAS u32x4*)(sb + n * 144 + c8 * 16);
        const int nn = c.n0 + n, dr = c.plain ? nn : (nn >> 7) * 256 + c.radd + (nn & 127);
        __builtin_nontemporal_store(o, (GAS u32x4*)(c.dst + (size_t)dr * c.K + 8 * c8)); }
    LDS_WAIT(); asm volatile("" ::: "memory");
}
__device__ __forceinline__ void cv64_batch3(const Args& a, LAS float* scr, int idx0, int stride, int layer, int lane) {
    const int total = 3 * 16 * 896;
    if (idx0 + 2 * stride < total) {
        const CvItem c0 = cv64_item(a, idx0, layer), c1 = cv64_item(a, idx0 + stride, layer), c2 = cv64_item(a, idx0 + 2 * stride, layer);
        { float R0[64], R1[64];
          __builtin_amdgcn_sched_barrier(0);
          cv64_load(c0, lane, R0); cv64_load(c1, lane, R1);
          __builtin_amdgcn_sched_barrier(0);
          cv64_finish(c0, scr, lane, R0); cv64_finish(c1, scr, lane, R1); }
        __builtin_amdgcn_sched_barrier(0);
        { float R2[64]; cv64_load(c2, lane, R2); cv64_finish(c2, scr, lane, R2); }
    } else {
#pragma unroll 1
        for (int k = 0; k < 3; ++k) { const int idx = idx0 + k * stride; if (idx < total) { const CvItem c0 = cv64_item(a, idx, layer); float R0[64]; cv64_load(c0, lane, R0); cv64_finish(c0, scr, lane, R0); } }
    }
}
__device__ __forceinline__ void spatial_phase(const Args& a, LAS unsigned char* lds, int G, int vcu) {
    const int tid = threadIdx.x, lane = tid & 63, wid = __builtin_amdgcn_readfirstlane(tid >> 6), fr = lane & 15, fq = lane >> 4;
    unsigned char* ws = a.ws;
    const bf16* U = (const bf16*)(ws + WS_U); const bf16* V = (const bf16*)(ws + WS_V); bf16* S = (bf16*)(ws + WS_S);
    const f32x2* vstat = (const f32x2*)(ws + WS_VSTAT); const bf16* wsp = (const bf16*)(ws + WS_WSP);
    LAS unsigned char* vt = lds;
    LAS float* mu = (LAS float*)(lds + 102400); LAS float* rs = mu + 128;
    LAS float* lg = rs + 128; LAS float* lb = lg + GW;
    for (int unit = vcu; unit < 128 * NGRP; unit += G) {
        const int grp = unit & 7, chunk = unit >> 3, row0 = chunk * CHUNK, c0 = grp * GW;
        __syncthreads();
        if (tid < 128) { const GAS f32x4* p4 = (const GAS f32x4*)(vstat + (size_t)(row0 + tid) * 48); float s1 = 0.f, s2 = 0.f;
            f32x4 q4[24];
#pragma unroll
            for (int j = 0; j < 24; ++j) q4[j] = p4[j];
#pragma unroll
            for (int j = 0; j < 24; ++j) { s1 += q4[j].x + q4[j].z; s2 += q4[j].y + q4[j].w; }
            const float m = s1 * (1.0f / AIN), var = s2 * (1.0f / AIN) - m * m; mu[tid] = m; rs[tid] = 1.0f / sqrtf(fmaxf(var, 0.f) + EPS); }
        for (int i = tid; i < GW; i += NTHR) { lg[i] = a.in[I_ALNG][c0 + i]; lb[i] = a.in[I_ALNB][c0 + i]; }
        __syncthreads();
        bf16x8 Yf[20];
#pragma unroll
        for (int ks = 0; ks < 4; ++ks)
#pragma unroll
            for (int mt = 2 * ks; mt < 8; ++mt) Yf[(ks == 0 ? 0 : ks == 1 ? 8 : ks == 2 ? 14 : 18) + mt - 2 * ks] = *(const GAS bf16x8*)(wsp + ((size_t)grp * CHUNK + 16 * mt + fr) * CHUNK + 32 * ks + 8 * fq);
#pragma unroll 1
        for (int i0 = 0; i0 < 12; i0 += 6) {
        u32x4 rawv[6];
#pragma unroll
        for (int i = 0; i < 6; ++i) { const int ch = tid + (i0 + i) * NTHR, s = ch / 48, cc = ch % 48; rawv[i] = *(const GAS u32x4*)(V + (size_t)(row0 + s) * AIN + c0 + cc * 8); }
#pragma unroll
        for (int i = 0; i < 6; ++i) { const int ch = tid + (i0 + i) * NTHR, s = ch / 48, cc = ch % 48;
            const u32x4 raw = rawv[i];
            const float m = mu[s], r = rs[s]; const LAS float* g8 = lg + cc * 8; const LAS float* b8 = lb + cc * 8;
            float x[8] = {bflo(raw.x), bfhi(raw.x), bflo(raw.y), bfhi(raw.y), bflo(raw.z), bfhi(raw.z), bflo(raw.w), bfhi(raw.w)};
#pragma unroll
            for (int j = 0; j < 8; ++j) x[j] = (x[j] - m) * r * g8[j] + b8[j];
            u32x4 w; w.x = cvt_pk_bf16(x[0], x[1]); w.y = cvt_pk_bf16(x[2], x[3]); w.z = cvt_pk_bf16(x[4], x[5]); w.w = cvt_pk_bf16(x[6], x[7]);
            *(LAS u32x4*)(vt + s * SG_STRIDE + cc * 16) = w; }
        }
        __syncthreads();
        f32x4 acc[8][3];
#pragma unroll
        for (int mt = 0; mt < 8; ++mt)
#pragma unroll
            for (int n = 0; n < 3; ++n) acc[mt][n] = (f32x4){0.f, 0.f, 0.f, 0.f};
        const int q = fr >> 2, p = fr & 3;
#pragma unroll
        for (int ks = 0; ks < 4; ++ks) {
            bf16x8 X[3];
#pragma unroll
            for (int n = 0; n < 3; ++n) { const LAS unsigned char* bp = vt + (32 * ks + 8 * fq + q) * SG_STRIDE + (48 * wid + 16 * n + 4 * p) * 2;
                const bf16x4 lo = lds_tr16(bp), hi = lds_tr16(bp + 4 * SG_STRIDE);
                X[n] = (bf16x8){lo[0], lo[1], lo[2], lo[3], hi[0], hi[1], hi[2], hi[3]}; }
#pragma unroll
            for (int mt = 2 * ks; mt < 8; ++mt) {
                const bf16x8 Y = Yf[(ks == 0 ? 0 : ks == 1 ? 8 : ks == 2 ? 14 : 18) + mt - 2 * ks];
#pragma unroll
                for (int n = 0; n < 3; ++n) acc[mt][n] = __builtin_amdgcn_mfma_f32_16x16x32_bf16(X[n], Y, acc[mt][n], 0, 0, 0);
            }
        }
#pragma unroll
        for (int mt = 0; mt < 8; ++mt) { const int t = 16 * mt + fr; const float bs = a.in[I_ABSP][grp * CHUNK + t];
#pragma unroll
            for (int n = 0; n < 3; ++n) { const size_t off = (size_t)(row0 + t) * AIN + c0 + 48 * wid + 16 * n + 4 * fq;
                const u32x2 uu = *(const GAS u32x2*)(U + off); const f32x4 x = acc[mt][n];
                *(GAS u32x2*)(S + off) = (u32x2){cvt_pk_bf16(bflo(uu.x) * (x[0] + bs), bfhi(uu.x) * (x[1] + bs)), cvt_pk_bf16(bflo(uu.y) * (x[2] + bs), bfhi(uu.y) * (x[3] + bs))}; } }
        __syncthreads();
        { const int uidx = (unit - vcu) / G, NGW = G * NWAVES, gwv = vcu * NWAVES + wid;
          LAS float* cscr = (LAS float*)(lds + wid * 9216);
#pragma unroll 1
          for (int k0 = 0; k0 < 6; k0 += 3) cv64_batch3(a, cscr, (uidx * 6 + k0) * NGW + gwv, NGW, 0, lane); }
    }
    __syncthreads();
}


__device__ __forceinline__ void router_phase(const Args& a, LAS unsigned char* lds, int layer, const float* hin, int vcu) {
    const int tid = threadIdx.x, lane = tid & 63, wid = __builtin_amdgcn_readfirstlane(tid >> 6);
    unsigned char* ws = a.ws;
    LAS float* rw = (LAS float*)lds;
    LAS float* vsc = (LAS float*)(lds + 65536); LAS float* vsh = vsc + D;
    LAS int* ent = (LAS int*)(lds + 65536 + 8192);
    LAS int* lrank = ent + 128; LAS int* lbase = lrank + 128;
    LAS float* gts = (LAS float*)(lbase + 16);
    const int row0 = vcu * 64, b = row0 / SEQ;
    for (int i = tid; i < D * NE; i += NTHR) rw[(i & 15) * D + (i >> 4)] = a.in[I_RW][i];
    load_norm_vecs(a, false, layer, b, 3, a.in[I_N2G] + layer * D, vsc, vsh);
    __syncthreads();
    bf16* HN = (bf16*)(ws + WS_HN);
    f32x4 vv[8][4];
#pragma unroll
    for (int i = 0; i < 8; ++i) { const GAS f32x4* xr = (const GAS f32x4*)(hin + (size_t)(row0 + wid * 8 + i) * D) + lane;
#pragma unroll
        for (int j = 0; j < 4; ++j) vv[i][j] = xr[64 * j]; }
#pragma unroll
    for (int i = 0; i < 8; ++i) {
        const int lr = wid * 8 + i, row = row0 + lr;
        f32x4 (&v)[4] = vv[i];
        rms_mod_row(v, vsc, vsh, lane);
        store_row_bf16(v, HN + (size_t)row * D, lane);
        float lg[16];
#pragma unroll
        for (int e = 0; e < 16; ++e) lg[e] = 0.f;
#pragma unroll
        for (int j = 0; j < 4; ++j)
#pragma unroll
            for (int e = 0; e < 16; ++e) { const f32x4 w = *(const LAS f32x4*)(rw + e * D + 4 * lane + 256 * j); const f32x4 x = v[j];
                lg[e] += (x.x * w.x + x.y * w.y) + (x.z * w.z + x.w * w.w); }
#pragma unroll
        for (int e = 0; e < 16; ++e) lg[e] = wave_sum(lg[e]);
        float aff[16], sel[16];
#pragma unroll
        for (int e = 0; e < 16; ++e) { aff[e] = 1.0f / (1.0f + expf(-lg[e])); sel[e] = aff[e] + a.in[I_RB][e]; }
        int grp = 0; float best = -1e30f;
#pragma unroll
        for (int g = 0; g < 4; ++g) { const float s0 = sel[4 * g], s1 = sel[4 * g + 1], s2 = sel[4 * g + 2], s3 = sel[4 * g + 3];
            const float tot = s0 + s1 + s2 + s3, mn1 = fminf(fminf(s0, s1), fminf(s2, s3));
            float m2 = fmaxf(fmaxf(fmaxf(s0 + s1, s0 + s2), fmaxf(s0 + s3, s1 + s2)), fmaxf(s1 + s3, s2 + s3)); (void)tot; (void)mn1;
            if (m2 > best) { best = m2; grp = g; } }
        float sg[4], ag[4];
#pragma unroll
        for (int j = 0; j < 4; ++j) { sg[j] = 0.f; ag[j] = 0.f; }
#pragma unroll
        for (int g = 0; g < 4; ++g) if (g == grp) {
#pragma unroll
            for (int j = 0; j < 4; ++j) { sg[j] = sel[4 * g + j]; ag[j] = aff[4 * g + j]; } }
        int i0 = 0; float b0 = sg[0];
#pragma unroll
        for (int j = 1; j < 4; ++j) if (sg[j] > b0) { b0 = sg[j]; i0 = j; }
        int i1 = 0; float b1 = -1e30f;
#pragma unroll
        for (int j = 0; j < 4; ++j) if (j != i0 && sg[j] > b1) { b1 = sg[j]; i1 = j; }
        float a0 = 0.f, a1 = 0.f;
#pragma unroll
        for (int j = 0; j < 4; ++j) { if (j == i0) a0 = ag[j]; if (j == i1) a1 = ag[j]; }
        const float inv = 1.0f / (a0 + a1);
        if (lane == 0) { ent[2 * lr] = grp * 4 + i0; ent[2 * lr + 1] = grp * 4 + i1; gts[2 * lr] = a0 * inv; gts[2 * lr + 1] = a1 * inv; }
    }
    __syncthreads();
    if (tid < 16) { int c = 0; for (int i = 0; i < 128; ++i) if (ent[i] == tid) lrank[i] = c++;
        ((unsigned*)(ws + WS_HIST))[(size_t)vcu * 16 + tid] = (unsigned)c; }
    __syncthreads();
}
__device__ __forceinline__ void router_finish(const Args& a, LAS unsigned char* lds, int layer, int vcu, int G) {
    const int tid = threadIdx.x; unsigned char* ws = a.ws;
    LAS int* ent = (LAS int*)(lds + 65536 + 8192); LAS int* lrank = ent + 128; LAS int* lbase = lrank + 128; LAS float* gts = (LAS float*)(lbase + 16);
    const int row0 = vcu * 64;
    LAS unsigned* hl = (LAS unsigned*)lds;
    for (int i = tid; i < G * 4; i += NTHR) *(LAS u32x4*)(hl + 4 * i) = *(const GAS u32x4*)((const unsigned*)(ws + WS_HIST) + 4 * i);
    __syncthreads();
    if (tid < 16) { unsigned base = 0u, tot = 0u;
        for (int b = 0; b < G; ++b) { const unsigned c = hl[b * 16 + tid]; tot += c; if (b < vcu) base += c; }
        lbase[tid] = (int)base;
        if (vcu == 0) __hip_atomic_store((unsigned*)(ws + WS_CTL) + CW_CNT + layer * 1024 + tid * 64, tot, __ATOMIC_RELAXED, __HIP_MEMORY_SCOPE_AGENT); }
    __syncthreads();
    if (tid < 128) { const int e = ent[tid], r = lbase[e] + lrank[tid], tok = row0 + (tid >> 1);
        ((unsigned*)(ws + WS_LIST))[(size_t)e * M + r] = (unsigned)tok;
        ((unsigned*)(ws + WS_TOKINFO))[(size_t)tok * 2 + (tid & 1)] = (unsigned)e | ((unsigned)r << 8);
        ((float*)(ws + WS_TOKINFO + 131072))[(size_t)tok * 2 + (tid & 1)] = gts[tid]; }
    __syncthreads();
}
__device__ __forceinline__ void moe_tables(const Args& a, volatile LAS int* tab, int layer, int ncol) {
    if (threadIdx.x < 64) {
        const int lane = threadIdx.x; const unsigned* cnt = (const unsigned*)(a.ws + WS_CTL) + CW_CNT + layer * 1024;
        const int c = lane < 16 ? (int)__hip_atomic_load(cnt + lane * 64, __ATOMIC_RELAXED, __HIP_MEMORY_SCOPE_AGENT) : 0;
        const int tiles = (c + 255) >> 8; int incl = tiles;
#pragma unroll
        for (int o = 1; o < 16; o <<= 1) { const int u = __shfl_up(incl, o); if (lane >= o) incl += u; }
        const int tp = incl - tiles;
        if (lane < 16) { tab[lane] = tp * ncol; tab[17 + lane] = tiles > 0 ? tiles : 1; tab[33 + lane] = tp * 256; tab[49 + lane] = c; }
        if (lane == 15) { tab[16] = incl * ncol; tab[65] = incl * ncol; }
    }
    __syncthreads();
}
__device__ __forceinline__ void combine_phase(const Args& a, LAS unsigned char* lds, int layer, const float* hin, float* hout, bool do_moe, bool final_, int vcu) {
    const int tid = threadIdx.x, lane = tid & 63, wid = __builtin_amdgcn_readfirstlane(tid >> 6);
    unsigned char* ws = a.ws;
    LAS float* vsc = (LAS float*)lds; LAS float* vsh = vsc + D; LAS float* g2 = vsh + D; LAS int* hr0 = (LAS int*)(g2 + D);
    const int row0 = vcu * 64, b = row0 / SEQ;
    if (final_) { for (int d = tid; d < D; d += NTHR) { vsc[d] = a.in[I_FG][d]; vsh[d] = 0.f; } }
    else load_norm_vecs(a, false, layer + 1, b, 0, a.in[I_N1G] + (layer + 1) * D, vsc, vsh);
    for (int d = tid; d < D; d += NTHR) g2[d] = mod_val(a, false, layer, b, 5 * 1024 + d);
    LAS int* ust = hr0 + 16; LAS int* tl = ust + 16; LAS int* nwgp = tl + 16;
    if (tid < 64) { const unsigned* cnt = (const unsigned*)(ws + WS_CTL) + CW_CNT + layer * 1024;
        const int c = tid < 16 ? (int)__hip_atomic_load(cnt + tid * 64, __ATOMIC_RELAXED, __HIP_MEMORY_SCOPE_AGENT) : 0;
        const int tiles = (c + 255) >> 8; int incl = tiles;
#pragma unroll
        for (int o = 1; o < 16; o <<= 1) { const int u = __shfl_up(incl, o); if (tid >= o) incl += u; }
        const int tp = incl - tiles;
        if (tid < 16) { hr0[tid] = tp * 256; ust[tid] = tp * (D / 256); tl[tid] = tiles > 0 ? tiles : 1; }
        if (tid == 15) nwgp[0] = incl * (D / 256); }
    __syncthreads();
    const bf16* Y = (const bf16*)(ws + WS_YSLOT); const bf16* SLB = (const bf16*)(ws + WS_SLAB);
    const int nwg_d = nwgp[0]; const bool split = (gridDim.x == 256) && nwg_d > 512 && nwg_d - 512 <= 64;
    u32x2 tiv[8]; f32x2 gwv[8];
#pragma unroll
    for (int i = 0; i < 8; ++i) { const int row = row0 + wid * 8 + i; tiv[i] = (u32x2){0u, 0u}; gwv[i] = (f32x2){0.f, 0.f};
        if (do_moe) { tiv[i] = *(const GAS u32x2*)((const unsigned*)(ws + WS_TOKINFO) + (size_t)row * 2); gwv[i] = *(const GAS f32x2*)((const float*)(ws + WS_TOKINFO + 131072) + (size_t)row * 2); } }
#pragma unroll
    for (int i = 0; i < 8; ++i) {
        const int row = row0 + wid * 8 + i;
        f32x4 v[4]; const GAS f32x4* xr = (const GAS f32x4*)(hin + (size_t)row * D) + lane;
#pragma unroll
        for (int j = 0; j < 4; ++j) v[j] = xr[64 * j];
        if (do_moe) {
            const u32x2 ti = tiv[i];
            const f32x2 gw = gwv[i];
            const int e0 = (int)(ti.x & 255u), r0 = (int)(ti.x >> 8), e1 = (int)(ti.y & 255u), r1 = (int)(ti.y >> 8);
            const int s0 = hr0[e0] + r0, s1 = hr0[e1] + r1;
            const float w0 = gw.x, w1 = gw.y;
            const GAS u32x2* y0 = (const GAS u32x2*)(Y + (size_t)s0 * D) + lane; const GAS u32x2* y1 = (const GAS u32x2*)(Y + (size_t)s1 * D) + lane;
            u32x2 yv0[4], yv1[4];
#pragma unroll
            for (int j = 0; j < 4; ++j) { yv0[j] = y0[64 * j]; yv1[j] = y1[64 * j]; }
#pragma unroll
            for (int j = 0; j < 4; ++j) { const f32x4 gg = *(const LAS f32x4*)(g2 + 4 * lane + 256 * j);
                f32x4 a0 = {bflo(yv0[j].x), bfhi(yv0[j].x), bflo(yv0[j].y), bfhi(yv0[j].y)}, a1 = {bflo(yv1[j].x), bfhi(yv1[j].x), bflo(yv1[j].y), bfhi(yv1[j].y)};
                const int wg0 = ust[e0] + j * tl[e0] + (r0 >> 8), wg1 = ust[e1] + j * tl[e1] + (r1 >> 8);
                if (split && wg0 >= 512) { const GAS u32x2* sp = (const GAS u32x2*)(SLB + (size_t)(wg0 - 512) * 4 * 65536 + (size_t)(r0 & 255) * 256) + lane; a0 = (f32x4){0.f, 0.f, 0.f, 0.f};
#pragma unroll
                    for (int q = 0; q < 4; ++q) { const u32x2 w = sp[q * 16384]; a0 = a0 + (f32x4){bflo(w.x), bfhi(w.x), bflo(w.y), bfhi(w.y)}; } }
                if (split && wg1 >= 512) { const GAS u32x2* sp = (const GAS u32x2*)(SLB + (size_t)(wg1 - 512) * 4 * 65536 + (size_t)(r1 & 255) * 256) + lane; a1 = (f32x4){0.f, 0.f, 0.f, 0.f};
#pragma unroll
                    for (int q = 0; q < 4; ++q) { const u32x2 w = sp[q * 16384]; a1 = a1 + (f32x4){bflo(w.x), bfhi(w.x), bflo(w.y), bfhi(w.y)}; } }
                v[j] = v[j] + gg * (a0 * w0 + a1 * w1); }
        }
        if (!final_) { GAS f32x4* o = (GAS f32x4*)(hout + (size_t)row * D) + lane;
#pragma unroll
            for (int j = 0; j < 4; ++j) o[64 * j] = v[j]; }
        rms_mod_row(v, vsc, vsh, lane);
        if (final_) { GAS f32x4* o = (GAS f32x4*)(a.out + (size_t)row * D) + lane;
            if (__hip_atomic_load((const unsigned*)(ws + WS_CTL) + CW_BAR + XB_TMO, __ATOMIC_RELAXED, __HIP_MEMORY_SCOPE_AGENT) != 0u) {
#pragma unroll
                for (int j = 0; j < 4; ++j) v[j] = v[j] + 1000.0f; }
#pragma unroll
            for (int j = 0; j < 4; ++j) o[64 * j] = v[j]; }
        else store_row_bf16(v, (bf16*)(ws + WS_HN) + (size_t)row * D, lane);
    }
    __syncthreads();
}


template <int KD, int ND, bool INF32>
__device__ __forceinline__ void headgemm(const void* in, int rs, int hs, const bf16* W, int wns, int whs, bf16* out, int ors, int ohs, float scale, int gw, int NGW, int lane) {
    const int fr = lane & 15, fq = lane >> 4;
    constexpr int KS = KD / 32, NT = ND / 16;
    const int h = gw & 15;
    bf16x8 Xf[NT][KS];
#pragma unroll
    for (int nt = 0; nt < NT; ++nt)
#pragma unroll
        for (int ks = 0; ks < KS; ++ks) Xf[nt][ks] = *(const GAS bf16x8*)(W + (size_t)(16 * nt + fr) * wns + h * whs + 32 * ks + 8 * fq);
    constexpr int NR = INF32 ? 2 * KS : KS;
    auto loadY = [&](int item, u32x4 (&R)[NR]) __attribute__((always_inline)) {
        const int t0 = (item >> 4) * 16;
#pragma unroll
        for (int ks = 0; ks < KS; ++ks) {
            if (INF32) { const float* p = (const float*)in + (size_t)(t0 + fr) * rs + h * hs + 32 * ks + 8 * fq; R[2 * ks] = *(const GAS u32x4*)p; R[2 * ks + 1] = *(const GAS u32x4*)(p + 4); }
            else R[ks] = *(const GAS u32x4*)((const bf16*)in + (size_t)(t0 + fr) * rs + h * hs + 32 * ks + 8 * fq);
        }
    };
    auto compute = [&](int item, const u32x4 (&R)[NR]) __attribute__((always_inline)) {
        const int t0 = (item >> 4) * 16;
        bf16x8 Y[KS];
#pragma unroll
        for (int ks = 0; ks < KS; ++ks) {
            if (INF32) { const f32x4 x0 = __builtin_bit_cast(f32x4, R[2 * ks]), x1 = __builtin_bit_cast(f32x4, R[2 * ks + 1]);
                const u32x4 w = {cvt_pk_bf16(x0[0], x0[1]), cvt_pk_bf16(x0[2], x0[3]), cvt_pk_bf16(x1[0], x1[1]), cvt_pk_bf16(x1[2], x1[3])}; Y[ks] = __builtin_bit_cast(bf16x8, w); }
            else Y[ks] = __builtin_bit_cast(bf16x8, R[ks]);
        }
#pragma unroll
        for (int nt = 0; nt < NT; ++nt) {
            f32x4 acc = {0.f, 0.f, 0.f, 0.f};
#pragma unroll
            for (int ks = 0; ks < KS; ++ks) acc = __builtin_amdgcn_mfma_f32_16x16x32_bf16(Xf[nt][ks], Y[ks], acc, 0, 0, 0);
            *(GAS u32x2*)(out + (size_t)(t0 + fr) * ors + h * ohs + 16 * nt + 4 * fq) = (u32x2){cvt_pk_bf16(acc[0] * scale, acc[1] * scale), cvt_pk_bf16(acc[2] * scale, acc[3] * scale)};
        }
    };
    const int total = (M / 16) * NH, n = gw < total ? (total - gw + NGW - 1) / NGW : 0;
    u32x4 RA[NR], RB[NR];
    int k = 0;
    if (n > 0) loadY(gw, RA);
    __builtin_amdgcn_sched_barrier(0);
#pragma unroll 1
    while (k + 2 < n) {
        loadY(gw + (k + 1) * NGW, RB);
        __builtin_amdgcn_sched_barrier(0);
        compute(gw + k * NGW, RA);
        __builtin_amdgcn_sched_barrier(0);
        loadY(gw + (k + 2) * NGW, RA);
        __builtin_amdgcn_sched_barrier(0);
        compute(gw + (k + 1) * NGW, RB);
        __builtin_amdgcn_sched_barrier(0);
        k += 2;
    }
    if (n - k == 2) { loadY(gw + (k + 1) * NGW, RB); __builtin_amdgcn_sched_barrier(0); compute(gw + k * NGW, RA); __builtin_amdgcn_sched_barrier(0); compute(gw + (k + 1) * NGW, RB); }
    else if (n - k == 1) compute(gw + k * NGW, RA);
}
__device__ __forceinline__ void post_phase(const Args& a, int gw, int NGW, int lane) {
    unsigned char* ws = a.ws;
    const float* P = (const float*)(ws + WS_PROJ);
    f32x4 cv[8], qa[8], qb[8]; float kk[8], ww[8];
#pragma unroll
    for (int i = 0; i < 8; ++i) { const float* pr = P + (size_t)(gw + i * NGW) * NPROJ;
        cv[i] = *(const GAS f32x4*)(pr + O_CKV + 4 * lane); qa[i] = *(const GAS f32x4*)(pr + O_QI + 8 * lane); qb[i] = *(const GAS f32x4*)(pr + O_QI + 8 * lane + 4);
        kk[i] = pr[O_KI + lane]; ww[i] = pr[O_WI + (lane & (HI - 1))]; }
    const f32x4 g = *(const GAS f32x4*)(a.in[I_BKVG] + 4 * lane); const float kg = a.in[I_BKIG][lane];
#pragma unroll
    for (int i = 0; i < 8; ++i) { const int row = gw + i * NGW; const f32x4 c = cv[i];
        const float r1 = 1.0f / sqrtf(wave_sum((c.x * c.x + c.y * c.y) + (c.z * c.z + c.w * c.w)) * (1.0f / CL) + EPS);
        *(GAS u32x2*)((bf16*)(ws + WS_CKV) + (size_t)row * CL + 4 * lane) = (u32x2){cvt_pk_bf16(c.x * r1 * g.x, c.y * r1 * g.y), cvt_pk_bf16(c.z * r1 * g.z, c.w * r1 * g.w)};
        const f32x4 q0 = qa[i], q1 = qb[i];
        *(GAS u32x4*)((bf16*)(ws + WS_QI) + (size_t)row * 512 + 8 * lane) = (u32x4){cvt_pk_bf16(q0.x, q0.y), cvt_pk_bf16(q0.z, q0.w), cvt_pk_bf16(q1.x, q1.y), cvt_pk_bf16(q1.z, q1.w)};
        const float k = kk[i];
        const float r2 = 1.0f / sqrtf(wave_sum(k * k) * (1.0f / DI) + EPS);
        ((bf16*)(ws + WS_KI))[(size_t)row * DI + lane] = (bf16)f2bf(k * r2 * kg);
        if (lane < HI) ((float*)(ws + WS_WI))[(size_t)row * HI + lane] = ww[i] * 0.04419417382415922f;
    }
    headgemm<HD, CL, true>(P, NPROJ, HD, (const bf16*)(ws + WS_WUK), NH * HD, HD, (bf16*)(ws + WS_QABS), NH * CL, CL, 0.125f, gw, NGW, lane);
}
__device__ __forceinline__ void indexer_phase(const Args& a, int G, int vcu) {
    const int tid = threadIdx.x, lane = tid & 63, wid = __builtin_amdgcn_readfirstlane(tid >> 6), fr = lane & 15, fq = lane >> 4;
    unsigned char* ws = a.ws;
    const bf16* QI = (const bf16*)(ws + WS_QI); const bf16* KI = (const bf16*)(ws + WS_KI); const float* WI = (const float*)(ws + WS_WI); float* SC = (float*)(ws + WS_SC);
    for (int u = vcu; u < NB_ * 528; u += G) {
        const int b = u / 528, r = u % 528;
        int tb = (int)((sqrtf(8.f * r + 1.f) - 1.f) * 0.5f); while ((tb + 1) * (tb + 2) / 2 <= r) ++tb; while (tb * (tb + 1) / 2 > r) --tb;
        const int sb = r - tb * (tb + 1) / 2;
        const int trow = b * SEQ + tb * 128 + 16 * wid + fr, srow0 = b * SEQ + sb * 128;
        bf16x8 Kf[8][2];
#pragma unroll
        for (int n = 0; n < 8; ++n)
#pragma unroll
            for (int ks = 0; ks < 2; ++ks) Kf[n][ks] = *(const GAS bf16x8*)(KI + (size_t)(srow0 + 16 * n + fr) * DI + 32 * ks + 8 * fq);
        f32x4 sc[8];
#pragma unroll
        for (int n = 0; n < 8; ++n) sc[n] = (f32x4){0.f, 0.f, 0.f, 0.f};
        const bf16* qrow = QI + (size_t)trow * 512 + 8 * fq;
        const f32x4 wq0 = *(const GAS f32x4*)(WI + (size_t)trow * HI), wq1 = *(const GAS f32x4*)(WI + (size_t)trow * HI + 4);
        bf16x8 QA0 = *(const GAS bf16x8*)(qrow), QA1 = *(const GAS bf16x8*)(qrow + 32), QB0, QB1;
#define IDX_HEAD(q0_, q1_, w_) do { _Pragma("unroll") for (int n = 0; n < 8; ++n) { f32x4 acc = {0.f, 0.f, 0.f, 0.f}; \
            acc = __builtin_amdgcn_mfma_f32_16x16x32_bf16(Kf[n][0], q0_, acc, 0, 0, 0); acc = __builtin_amdgcn_mfma_f32_16x16x32_bf16(Kf[n][1], q1_, acc, 0, 0, 0); \
            _Pragma("unroll") for (int j = 0; j < 4; ++j) sc[n][j] += (w_) * __builtin_amdgcn_fmed3f(acc[j], 0.f, 3.0e38f); } } while (0)
#pragma unroll 1
        for (int hp = 0; hp < 4; ++hp) {
            const f32x4 wv = hp < 2 ? wq0 : wq1; const float wa = (hp & 1) ? wv.z : wv.x, wb = (hp & 1) ? wv.w : wv.y;
            QB0 = *(const GAS bf16x8*)(qrow + (2 * hp + 1) * 64); QB1 = *(const GAS bf16x8*)(qrow + (2 * hp + 1) * 64 + 32);
            __builtin_amdgcn_sched_barrier(0);
            IDX_HEAD(QA0, QA1, wa);
            __builtin_amdgcn_sched_barrier(0);
            if (hp < 3) { QA0 = *(const GAS bf16x8*)(qrow + (2 * hp + 2) * 64); QA1 = *(const GAS bf16x8*)(qrow + (2 * hp + 2) * 64 + 32); }
            __builtin_amdgcn_sched_barrier(0);
            IDX_HEAD(QB0, QB1, wb);
            __builtin_amdgcn_sched_barrier(0);
        }
#undef IDX_HEAD
#pragma unroll
        for (int n = 0; n < 8; ++n) *(GAS f32x4*)(SC + (size_t)trow * SEQ + sb * 128 + 16 * n + 4 * fq) = sc[n];
    }
}
__device__ __forceinline__ void topk_phase(const Args& a, LAS unsigned char* lds, int gw, int NGW, int wave, int lane) {
    LAS unsigned* hist = (LAS unsigned*)(lds + wave * 17408);
    LAS unsigned* cand = hist + 256;
    const float* SC = (const float*)(a.ws + WS_SC); int* SEL = (int*)(a.ws + WS_SEL);
    const unsigned long long lt = (1ull << lane) - 1ull;
    for (int ri = 0; ri < M / NGW; ++ri) {
        const int rr = gw + ri * NGW, bb = rr / SEQ, tt = rr % SEQ;
        const int t = (tt >= SEQ / 2) ? (3 * SEQ / 2 - 1 - tt) : tt, row = bb * SEQ + t, n = t + 1;
        int* sel = SEL + (size_t)row * KTOP;
        if (n <= KTOP) { for (int j = lane; j < KTOP; j += 64) sel[j] = j < n ? j : 0; continue; }
        const float* sc = SC + (size_t)row * SEQ;
        float v[64]; float mn = 3.0e38f, mx = -3.0e38f;
#pragma unroll
        for (int g = 0; g < 4; ++g) if (g * 1024 < n) {
#pragma unroll
            for (int jj = 0; jj < 16; ++jj) { const int j = g * 16 + jj, s2 = j * 64 + lane; v[j] = sc[s2]; } }
        else {
#pragma unroll
            for (int jj = 0; jj < 16; ++jj) v[g * 16 + jj] = 0.f; }
        __builtin_amdgcn_sched_barrier(0);
#pragma unroll
        for (int g = 0; g < 4; ++g) if (g * 1024 < n) {
#pragma unroll
            for (int jj = 0; jj < 16; ++jj) { const int j = g * 16 + jj, s2 = j * 64 + lane; const float xr = v[j]; const bool ok = s2 < n;
                mn = fminf(mn, ok ? xr : 3.0e38f); mx = fmaxf(mx, ok ? xr : -3.0e38f); v[j] = ok ? xr : 0.f; } }
#pragma unroll
        for (int o = 1; o < 64; o <<= 1) { mn = fminf(mn, __shfl_xor(mn, o)); mx = fmaxf(mx, __shfl_xor(mx, o)); }
        const float range = mx - mn, scale = range > 0.f ? 16777215.0f / range : 0.f;
        *(LAS u32x4*)(hist + 4 * lane) = (u32x4){0u, 0u, 0u, 0u};
        LDS_WAIT();
#pragma unroll
        for (int g = 0; g < 4; ++g) if (g * 1024 < n) {
#pragma unroll
            for (int jj = 0; jj < 16; ++jj) { const int j = g * 16 + jj, s2 = j * 64 + lane; unsigned k = (unsigned)((v[j] - mn) * scale); k = k > 0xFFFFFFu ? 0xFFFFFFu : k;
                v[j] = __builtin_bit_cast(float, k);
                if (s2 < n) __hip_atomic_fetch_add(hist + (k >> 16), 1u, __ATOMIC_RELAXED, __HIP_MEMORY_SCOPE_WORKGROUP); } }
        LDS_WAIT();
        const u32x4 h4 = *(LAS u32x4*)(hist + 4 * lane);
        const unsigned tot = h4.x + h4.y + h4.z + h4.w;
        unsigned suf = tot;
#pragma unroll
        for (int o = 1; o < 64; o <<= 1) { const unsigned u = __shfl_down(suf, o); if (lane + o < 64) suf += u; }
        const unsigned above = suf - tot, kr = (unsigned)KTOP;
        const bool here = (above < kr) && (suf >= kr);
        const unsigned long long bm = __ballot(here); const int L = bm ? (__ffsll((long long)bm) - 1) : 0;
        const unsigned c3 = above + h4.w, c2 = c3 + h4.z, c1 = c2 + h4.y;
        int binl; unsigned ab;
        if (c3 >= kr) { binl = 3; ab = above; } else if (c2 >= kr) { binl = 2; ab = c3; } else if (c1 >= kr) { binl = 1; ab = c2; } else { binl = 0; ab = c1; }
        const unsigned b0 = (unsigned)__shfl(4 * lane + binl, L); const int abv = (int)__shfl(ab, L); const int krem = KTOP - abv;
        int pos = 0, ccnt = 0;
#pragma unroll
        for (int g = 0; g < 4; ++g) if (g * 1024 < n) {
#pragma unroll
            for (int jj = 0; jj < 16; ++jj) { const int j = g * 16 + jj, s2 = j * 64 + lane; const unsigned k = __builtin_bit_cast(unsigned, v[j]); const unsigned d = k >> 16; const bool valid = s2 < n;
                const bool gt = valid && d > b0, eq = valid && d == b0;
                const unsigned long long gm = __ballot(gt), em = __ballot(eq);
                if (gt) sel[pos + __popcll(gm & lt)] = s2;
                if (eq) cand[ccnt + __popcll(em & lt)] = ((k & 0xFFFFu) << 12) | (unsigned)(4095 - s2);
                pos += __popcll(gm); ccnt += __popcll(em); } }
        LDS_WAIT();
        for (int i0 = 0; i0 < ccnt; i0 += 64) { const int i = i0 + lane; const unsigned mine = i < ccnt ? cand[i] : 0xFFFFFFFFu; int rank = 0;
            for (int q = 0; q < ccnt; ++q) rank += (cand[q] > mine) ? 1 : 0;
            if (i < ccnt && rank < krem) sel[abv + rank] = 4095 - (int)(mine & 4095u); }
        LDS_WAIT();
    }
}
__device__ const unsigned char T5_BUCKET[128] = {0,1,2,3,4,5,6,7,8,9,10,11,12,13,14,15,16,16,16,17,17,18,18,18,19,19,19,20,20,20,20,21,21,21,21,22,22,22,22,22,23,23,23,23,23,23,24,24,24,24,24,24,25,25,25,25,25,25,25,26,26,26,26,26,26,26,26,27,27,27,27,27,27,27,27,27,27,28,28,28,28,28,28,28,28,28,28,29,29,29,29,29,29,29,29,29,29,29,29,30,30,30,30,30,30,30,30,30,30,30,30,30,30,31,31,31,31,31,31,31,31,31,31,31,31,31,31,31};
constexpr int ATT_STG = 147456;
constexpr int ATT_PAIR = 1040, ATT_BUF = 8 * ATT_PAIR, ATT_TABO = NWAVES * 2 * ATT_BUF;
__device__ __forceinline__ void attn_phase(const Args& a, LAS unsigned char* lds, int vcu, int G, int wave, int lane) {
    const int tid = threadIdx.x, fr = lane & 15, fq = lane >> 4, q4 = fr >> 2, p4 = fr & 3;
    unsigned char* ws = a.ws;
    LAS unsigned char* kvb = lds + wave * (2 * ATT_BUF);
    LAS float* rb = (LAS float*)(lds + ATT_TABO); LAS int* bkt = (LAS int*)(lds + ATT_TABO + 2048);
    for (int i = tid; i < 32 * NH; i += NTHR) rb[i] = a.in[I_RELB][i];
    if (tid < 128) bkt[tid] = T5_BUCKET[tid];
    __syncthreads();
    const bf16* QABS = (const bf16*)(ws + WS_QABS); const unsigned char* CKVB = (const unsigned char*)(ws + WS_CKV); const int* SEL = (const int*)(ws + WS_SEL); bf16* OLAT = (bf16*)(ws + WS_OLAT);
    const int bpb = G / NB_, b = vcu / bpb, lb = vcu % bpb, nbw = bpb * NWAVES;
    const int trrow = 4 * fq + q4, trbase = (trrow >> 1) * ATT_PAIR + (trrow & 1) * 512 + 8 * (p4 & 1), trrot = (trrow & 1) ? 24 : 0;
    const int qbase = (fr >> 1) * ATT_PAIR + (fr & 1) * 512, qrot = (fr & 1) ? 24 : 0;
    LAS unsigned* kof = (LAS unsigned*)(lds + ATT_STG + wave * 2048); LAS int* bks = (LAS int*)(kof + 256);
    const int wpos = (lane >> 4) * 16 + (lane & 1) * 8 + ((lane & 15) >> 1);
    const unsigned lcx = (unsigned)((((lane & 31) + ((lane >> 5) << 3)) & 31) << 4);
    if (b < NB_)
    for (int t = lb * NWAVES + wave; t < SEQ; t += nbw) {
        const int row = b * SEQ + t, cnt = (t + 1 < KTOP) ? t + 1 : KTOP, nst = (cnt + 15) >> 4;
        bf16x8 Q[8];
#pragma unroll
        for (int ks = 0; ks < 8; ++ks) Q[ks] = *(const GAS bf16x8*)(QABS + ((size_t)row * NH + fr) * CL + 32 * ks + 8 * fq);
        const int* sel = SEL + (size_t)row * KTOP;
        const int sr0 = sel[lane], sr1 = sel[64 + lane], sr2 = sel[128 + lane], sr3 = sel[192 + lane];
        int br0, br1, br2, br3;
        { const int d0 = t - sr0, d1 = t - sr1, d2 = t - sr2, d3 = t - sr3;
          br0 = (d0 < 128 ? bkt[d0 < 0 ? 0 : d0] : 31) * NH; br1 = (d1 < 128 ? bkt[d1 < 0 ? 0 : d1] : 31) * NH; br2 = (d2 < 128 ? bkt[d2 < 0 ? 0 : d2] : 31) * NH; br3 = (d3 < 128 ? bkt[d3 < 0 ? 0 : d3] : 31) * NH; }
        const unsigned ko0 = (unsigned)(b * SEQ + sr0) * 512u, ko1 = (unsigned)(b * SEQ + sr1) * 512u, ko2 = (unsigned)(b * SEQ + sr2) * 512u, ko3 = (unsigned)(b * SEQ + sr3) * 512u;
        kof[wpos] = ko0; kof[64 + wpos] = ko1; kof[128 + wpos] = ko2; kof[192 + wpos] = ko3;
        bks[lane] = br0; bks[64 + lane] = br1; bks[128 + lane] = br2; bks[192 + lane] = br3;
        f32x4 o[16];
#pragma unroll
        for (int nt = 0; nt < 16; ++nt) o[nt] = (f32x4){0.f, 0.f, 0.f, 0.f};
        float mrun = -1e30f, lsum = 0.f;
        VM_WAIT();
#define ATT_DMA(st_) do { const int st__ = (st_); LAS unsigned char* dst_ = kvb + (st__ & 1) * ATT_BUF; \
        const u32x4 ka_ = *(const LAS u32x4*)(kof + st__ * 16 + (lane >> 5) * 8), kb_ = *(const LAS u32x4*)(kof + st__ * 16 + (lane >> 5) * 8 + 4); \
        const unsigned kk_[8] = {ka_.x, ka_.y, ka_.z, ka_.w, kb_.x, kb_.y, kb_.z, kb_.w}; \
        LDS_WAIT(); __builtin_amdgcn_sched_barrier(0); \
        _Pragma("unroll") for (int i_ = 0; i_ < 8; ++i_) \
            __builtin_amdgcn_global_load_lds((const unsigned*)(CKVB + (kk_[i_] + lcx)), (LAS unsigned*)(dst_ + i_ * ATT_PAIR), 16, 0, 0); } while (0)
        LDS_WAIT(); __builtin_amdgcn_sched_barrier(0);
        ATT_DMA(0);
        for (int st = 0; st < nst; ++st) {
            LAS unsigned char* kv = kvb + (st & 1) * ATT_BUF;
            const u32x4 b4_ = *(const LAS u32x4*)(bks + st * 16 + 4 * fq);
            const int bk4[4] = {(int)b4_.x, (int)b4_.y, (int)b4_.z, (int)b4_.w};
            LDS_WAIT(); __builtin_amdgcn_sched_barrier(0);
            if (st + 1 < nst) { ATT_DMA(st + 1); asm volatile("s_waitcnt vmcnt(8)" ::: "memory"); }
            else asm volatile("s_waitcnt vmcnt(0)" ::: "memory");
            __builtin_amdgcn_sched_barrier(0);
            f32x4 lg = {0.f, 0.f, 0.f, 0.f}, lg2 = {0.f, 0.f, 0.f, 0.f};
#pragma unroll
            for (int ks = 0; ks < 8; ks += 2) { const bf16x8 X = *(const LAS bf16x8*)(kv + qbase + (((4 * ks + fq + qrot) & 31) << 4)), X2 = *(const LAS bf16x8*)(kv + qbase + (((4 * (ks + 1) + fq + qrot) & 31) << 4));
                lg = __builtin_amdgcn_mfma_f32_16x16x32_bf16(X, Q[ks], lg, 0, 0, 0); lg2 = __builtin_amdgcn_mfma_f32_16x16x32_bf16(X2, Q[ks + 1], lg2, 0, 0, 0); }
            lg = lg + lg2;
            float x[4]; float mx = -1e30f;
#pragma unroll
            for (int j = 0; j < 4; ++j) x[j] = lg[j] + rb[bk4[j] + fr];
            if ((st + 1) * 16 > cnt) {
#pragma unroll
                for (int j = 0; j < 4; ++j) if (st * 16 + 4 * fq + j >= cnt) x[j] = -1e30f; }
#pragma unroll
            for (int j = 0; j < 4; ++j) mx = fmaxf(mx, x[j]);
            { const auto s16 = __builtin_amdgcn_permlane16_swap(__builtin_bit_cast(unsigned, mx), __builtin_bit_cast(unsigned, mx), false, false);
              mx = fmaxf(__builtin_bit_cast(float, (unsigned)s16[0]), __builtin_bit_cast(float, (unsigned)s16[1]));
              const auto s32 = __builtin_amdgcn_permlane32_swap(__builtin_bit_cast(unsigned, mx), __builtin_bit_cast(unsigned, mx), false, false);
              mx = fmaxf(__builtin_bit_cast(float, (unsigned)s32[0]), __builtin_bit_cast(float, (unsigned)s32[1])); }
            const float mnew = fmaxf(mrun, mx);
            if (__any(mnew > mrun)) { const float alpha = fast_exp(mrun - mnew); lsum *= alpha;
#pragma unroll
                for (int nt = 0; nt < 16; ++nt) o[nt] = o[nt] * alpha; }
            mrun = mnew;
            float pv[4]; float ps = 0.f;
#pragma unroll
            for (int j = 0; j < 4; ++j) { pv[j] = fast_exp(x[j] - mnew); ps += pv[j]; }
            lsum += ps;
            const u32x2 pw = {cvt_pk_bf16(pv[0], pv[1]), cvt_pk_bf16(pv[2], pv[3])};
            const bf16x4 Pf = __builtin_bit_cast(bf16x4, pw);
            {
                const unsigned kva = (unsigned)(size_t)kv + (unsigned)trbase;
                bf16x4 XA[4], XB[4];
#define ATT_TR(dst_, g_) _Pragma("unroll") for (int nt = 0; nt < 4; ++nt) asm volatile("ds_read_b64_tr_b16 %0, %1" : "=v"(dst_[nt]) : "v"(kva + (unsigned)(((2 * (nt + 4 * (g_)) + (p4 >> 1) + trrot) & 31) << 4)))
#define ATT_TW(x_) asm volatile("s_waitcnt lgkmcnt(0)" : "+v"(x_[0]), "+v"(x_[1]), "+v"(x_[2]), "+v"(x_[3]))
#define ATT_MM(x_, g_) _Pragma("unroll") for (int nt = 0; nt < 4; ++nt) o[nt + 4 * (g_)] = __builtin_amdgcn_mfma_f32_16x16x16bf16_1k(x_[nt], Pf, o[nt + 4 * (g_)], 0, 0, 0)
                ATT_TR(XA, 0); ATT_TW(XA); ATT_TR(XB, 1); ATT_MM(XA, 0); ATT_TW(XB); ATT_TR(XA, 2); ATT_MM(XB, 1); ATT_TW(XA); ATT_TR(XB, 3); ATT_MM(XA, 2); ATT_TW(XB); ATT_MM(XB, 3);
#undef ATT_TR
#undef ATT_TW
#undef ATT_MM
            }
        }
#undef ATT_DMA
        lsum += __shfl_xor(lsum, 16); lsum += __shfl_xor(lsum, 32);
        const float inv = 1.0f / lsum;
#pragma unroll
        for (int nt = 0; nt < 16; ++nt) *(GAS u32x2*)(OLAT + ((size_t)row * NH + fr) * CL + 16 * nt + 4 * fq) = (u32x2){cvt_pk_bf16(o[nt][0] * inv, o[nt][1] * inv), cvt_pk_bf16(o[nt][2] * inv, o[nt][3] * inv)};
        LDS_WAIT();
        { const int slot = (t - (lb * NWAVES + wave)) / nbw;
          const int gwv = (b * bpb + lb) * NWAVES + wave;
          const int NGWV = NB_ * bpb * NWAVES, total = 3 * 16 * 1792;
          cv64_batch3(a, (LAS float*)kvb, (slot * 3) * NGWV + gwv, NGWV, 1, lane); }
    }
    LDS_WAIT();
    __syncthreads();
}


constexpr int NPH = 20;
__global__ void __launch_bounds__(NTHR, 2) fwd(Args args) {
    extern __shared__ __attribute__((aligned(16))) unsigned char smem[];
    LAS unsigned char* lds = (LAS unsigned char*)smem;
    volatile LAS unsigned* MISC = (volatile LAS unsigned*)(lds + MISC_OFF);
    volatile LAS int* tab = (volatile LAS int*)(lds + MISC_OFF + 256);
    const int tid = threadIdx.x, lane = tid & 63, wave = __builtin_amdgcn_readfirstlane(tid >> 6);
    const int G = gridDim.x; const int bx = blockIdx.x; const int vcu = (G % 8 == 0) ? (bx % 8) * (G / 8) + bx / 8 : bx;
    const int gw = vcu * NWAVES + wave, NGW = G * NWAVES;
    unsigned char* ws = args.ws;
    if (tid < 64) MISC[tid] = 0u;
    __syncthreads();
    const int lo = args.ph_lo, hi = args.ph_hi;
    XcdBarrier bar; bar.bar = (unsigned*)(ws + WS_CTL) + CW_BAR; bar.x = 0; bar.st = nullptr;
    if (hi - lo > 1) bar = xcd_barrier_post((unsigned*)(ws + WS_CTL) + CW_BAR, MISC + 8);
#ifndef MK_MASK
#define MK_MASK 0xFFFFFu
#endif
#define IN(k) (((MK_MASK >> (k)) & 1u) && lo <= (k) && (k) < hi)
#ifndef MK_DBL
#define MK_DBL 0u
#endif
#define REP(k) for (int rep_ = 0; rep_ < (int)((MK_DBL >> (k)) & 1u) + 1; ++rep_)
#define SEAM(k) do { if (IN(k) && IN((k) + 1)) xcd_barrier(bar); } while (0)
    const float* X = args.in[I_X];
    float* HA = (float*)(ws + WS_HA); float* HB = (float*)(ws + WS_HB); bf16* HN = (bf16*)(ws + WS_HN);
    const float* MODF = (const float*)(ws + WS_MODF);

    if (IN(0)) REP(0) p0_prologue(args, lds, gw, NGW, wave, lane);
    SEAM(0);
    if (IN(1)) REP(1) {
        if (tid < 192) { const int idx = vcu * 192 + tid; if (idx < 49152) { float s = args.in[I_ADAB][(idx / 24576) * 6144 + idx % 6144]; const float* mp = (const float*)(ws + WS_MODP) + idx;
#pragma unroll
            for (int ks = 0; ks < 8; ++ks) s += mp[(size_t)ks * 49152];
            ((float*)(ws + WS_MODF))[idx] = s; } }
        LAS float* vsc = (LAS float*)lds; LAS float* vsh = vsc + D;
        const int row0 = vcu * 64, b = row0 / SEQ;
        load_norm_vecs(args, true, 0, b, 0, args.in[I_N1G], vsc, vsh);
        __syncthreads();
        f32x4 vv[8][4];
#pragma unroll
        for (int i = 0; i < 8; ++i) { const GAS f32x4* xr = (const GAS f32x4*)(X + (size_t)(row0 + wave * 8 + i) * D) + lane;
#pragma unroll
            for (int j = 0; j < 4; ++j) vv[i][j] = xr[64 * j]; }
#pragma unroll
        for (int i = 0; i < 8; ++i) { rms_mod_row(vv[i], vsc, vsh, lane); store_row_bf16(vv[i], HN + (size_t)(row0 + wave * 8 + i) * D, lane); }
        __syncthreads();
    }
    SEAM(1);
    if (IN(2)) REP(2) {
        pg8::DenseSched S; S.init(HN, (const bf16*)(ws + WS_WINA), M, NZ, D, G, bx);
        pg8::EpiGeluUV E{(bf16*)(ws + WS_U), (bf16*)(ws + WS_V), (f32x2*)(ws + WS_VSTAT)};
        pg8::gemm_phase(lds, S, E);
    }
    SEAM(2);
    if (IN(3)) REP(3) spatial_phase(args, lds, G, vcu);
    SEAM(3);
    if (IN(4)) REP(4) {
        pg8::DenseSched S; S.init((const bf16*)(ws + WS_S), (const bf16*)(ws + WS_WOUTA), M, D, AIN, G, bx);
        pg8::EpiResid E{X, HA, MODF + 0 * 24576 + 2 * 1024};
        pg8::gemm_phase(lds, S, E);
    }
    SEAM(4);
#if MK_STAGE >= 2
    if (IN(5)) REP(5) router_phase(args, lds, 0, HA, vcu);
    SEAM(5);
    if (IN(6)) REP(6) {
        router_finish(args, lds, 0, vcu, G); xcd_barrier(bar);
        moe_tables(args, tab, 0, NGU / 256);
        pg8::MoeSched S{HN, (const bf16*)(ws + WS_WGU), (const unsigned*)(ws + WS_LIST), tab, D, NGU / 256, G, bx, true, (size_t)NGU * D * 2, (LAS unsigned*)(lds + 132 * 1024), false};
        pg8::EpiSwiGLU E{(bf16*)(ws + WS_HMOE)};
        pg8::gemm_phase(lds, S, E);
    }
    SEAM(6);
    if (IN(7)) REP(7) {
        moe_tables(args, tab, 0, D / 256);
        pg8::MoeSched S{(const bf16*)(ws + WS_HMOE), (const bf16*)(ws + WS_WD), (const unsigned*)(ws + WS_LIST), tab, DE, D / 256, G, bx, false, (size_t)D * DE * 2, (LAS unsigned*)(lds + 132 * 1024), true};
        pg8::EpiYbf E{(bf16*)(ws + WS_YSLOT), (bf16*)(ws + WS_SLAB)};
        pg8::gemm_phase(lds, S, E);
    }
    SEAM(7);
    if (IN(8)) REP(8) combine_phase(args, lds, 0, HA, HB, true, false, vcu);
    SEAM(8);
#endif
#if MK_STAGE >= 3
    if (IN(9)) REP(9) {
        pg8::DenseSched S; S.init(HN, (const bf16*)(ws + WS_WINB), M, NPROJ, D, G, bx);
        pg8::EpiF32 E{(float*)(ws + WS_PROJ), NPROJ, nullptr};
        pg8::gemm_phase(lds, S, E);
    }
    SEAM(9);
    if (IN(10)) REP(10) post_phase(args, gw, NGW, lane);
    SEAM(10);
    if (IN(11)) REP(11) indexer_phase(args, G, vcu);
    SEAM(11);
    if (IN(12)) REP(12) topk_phase(args, lds, gw, NGW, wave, lane);
    SEAM(12);
    if (IN(13)) REP(13) attn_phase(args, lds, vcu, G, wave, lane);
    SEAM(13);
    if (IN(14)) REP(14) headgemm<CL, HD, false>((const void*)(ws + WS_OLAT), NH * CL, CL, (const bf16*)(ws + WS_WUVT), CL, HD * CL, (bf16*)(ws + WS_O), D, HD, 1.0f, gw, NGW, lane);
    SEAM(14);
    if (IN(15)) REP(15) {
        pg8::DenseSched S; S.init((const bf16*)(ws + WS_O), (const bf16*)(ws + WS_WOUTB), M, D, D, G, bx);
        pg8::EpiResid E{HB, HA, MODF + 1 * 24576 + 2 * 1024};
        pg8::gemm_phase(lds, S, E);
    }
    SEAM(15);
#endif
#if MK_STAGE >= 9
    if (IN(16)) REP(16) router_phase(args, lds, 1, HA, vcu);
    SEAM(16);
    if (IN(17)) REP(17) {
        router_finish(args, lds, 1, vcu, G); xcd_barrier(bar);
        moe_tables(args, tab, 1, NGU / 256);
        pg8::MoeSched S{HN, (const bf16*)(ws + WS_WGU) + (size_t)NE * NGU * D, (const unsigned*)(ws + WS_LIST), tab, D, NGU / 256, G, bx, true, (size_t)NGU * D * 2, (LAS unsigned*)(lds + 132 * 1024), false};
        pg8::EpiSwiGLU E{(bf16*)(ws + WS_HMOE)};
        pg8::gemm_phase(lds, S, E);
    }
    SEAM(17);
    if (IN(18)) REP(18) {
        moe_tables(args, tab, 1, D / 256);
        pg8::MoeSched S{(const bf16*)(ws + WS_HMOE), (const bf16*)(ws + WS_WD) + (size_t)NE * D * DE, (const unsigned*)(ws + WS_LIST), tab, DE, D / 256, G, bx, false, (size_t)D * DE * 2, (LAS unsigned*)(lds + 132 * 1024), true};
        pg8::EpiYbf E{(bf16*)(ws + WS_YSLOT), (bf16*)(ws + WS_SLAB)};
        pg8::gemm_phase(lds, S, E);
    }
    SEAM(18);
    if (IN(19)) REP(19) combine_phase(args, lds, 1, HA, nullptr, true, true, vcu);
#elif MK_STAGE >= 3
    if (IN(19)) REP(19) combine_phase(args, lds, 1, HA, nullptr, false, true, vcu);
#elif MK_STAGE >= 2
    if (IN(19)) REP(19) combine_phase(args, lds, 1, HB, nullptr, false, true, vcu);
#else
    if (IN(19)) REP(19) combine_phase(args, lds, 1, HA, nullptr, false, true, vcu);
#endif
#undef IN
#undef SEAM
}

extern "C" void kernel_launch(void* const* d_in, const int* in_sizes, int n_in, void* d_out, int out_size, void* d_ws, size_t ws_size, hipStream_t stream) {
    static int grid = 0;
    if (grid == 0) {
        if (n_in != 25 || in_sizes[0] != M * D || out_size != M * D || ws_size < WS_END) { fprintf(stderr, "kernel_launch: unexpected shapes / workspace (%d inputs, ws %zu < %zu)\n", n_in, ws_size, (size_t)WS_END); grid = -1; return; }
        int dev = 0, cus = 0, per_cu = 0;
        if (hipGetDevice(&dev) != hipSuccess || hipDeviceGetAttribute(&cus, hipDeviceAttributeMultiprocessorCount, dev) != hipSuccess) { grid = -1; return; }
        if (hipFuncSetAttribute((const void*)fwd, hipFuncAttributeMaxDynamicSharedMemorySize, LDS_BYTES) != hipSuccess) { fprintf(stderr, "kernel_launch: hipFuncSetAttribute failed\n"); grid = -1; return; }
        if (hipOccupancyMaxActiveBlocksPerMultiprocessor(&per_cu, (const void*)fwd, NTHR, LDS_BYTES) != hipSuccess || per_cu < 1) fprintf(stderr, "kernel_launch: occupancy query says %d\n", per_cu);
        (void)hipGetLastError();
        grid = cus;
    }
    if (grid < 0) return;
    if (hipMemsetAsync((char*)d_ws + WS_CTL, 0, CTL_ZERO_BYTES, stream) != hipSuccess) return;
    Args a{};
    for (int i = 0; i < 25; ++i) a.in[i] = (const float*)d_in[i];
    a.out = (float*)d_out; a.ws = (unsigned char*)d_ws;
    a.ph_lo = 0; a.ph_hi = NPH;
    hipLaunchKernelGGL(fwd, dim3(grid), dim3(NTHR), LDS_BYTES, stream, a);
}
```

```cpp
#include <hip/hip_runtime.h>
#include <cstdio>
#include <cstdint>

#ifndef MK_STAGE
#define MK_STAGE 9
#endif

#define GAS __attribute__((address_space(1)))
#define LAS __attribute__((address_space(3)))
typedef unsigned short bf16;
typedef short bf16x8 __attribute__((ext_vector_type(8)));
typedef short bf16x4 __attribute__((ext_vector_type(4)));
typedef float f32x4 __attribute__((ext_vector_type(4)));
typedef float f32x2 __attribute__((ext_vector_type(2)));
typedef unsigned u32x4 __attribute__((ext_vector_type(4)));
typedef unsigned u32x2 __attribute__((ext_vector_type(2)));
typedef int i32x4 __attribute__((ext_vector_type(4)));
typedef short v4i16_t __attribute__((ext_vector_type(4)));

constexpr int NB_ = 4, SEQ = 4096, D = 1024, M = NB_ * SEQ;
constexpr int AIN = 3072, NZ = 6144, NGRP = 8, GW = 384, CHUNK = 128;
constexpr int NH = 16, HD = 64, CL = 256, HI = 8, DI = 64, KTOP = 256;
constexpr int BPROJ = 1864, NPROJ = 2048;
constexpr int O_CKV = 1024, O_QI = 1280, O_KI = 1792, O_WI = 1856;
constexpr int NE = 16, DE = 3584, NGU = 7168;
constexpr int PMAX = 2 * M + NE * 256;
constexpr float EPS = 1e-6f;

constexpr size_t MiB = 1u << 20;
constexpr size_t WS_CTL = 0, CTL_ZERO_BYTES = 1 * MiB;
constexpr size_t WS_WINA = 2 * MiB, WS_WOUTA = 14 * MiB, WS_WINB = 20 * MiB, WS_WOUTB = 24 * MiB;
constexpr size_t WS_WUK = 26 * MiB, WS_WUVT = 26 * MiB + 512 * 1024, WS_WSP = 27 * MiB;
constexpr size_t WS_MODP = 28 * MiB, WS_MODF = 30 * MiB, WS_TOKINFO = 31 * MiB, WS_LIST = 31 * MiB + 512 * 1024;
constexpr size_t WS_HIST = 32 * MiB + 512 * 1024;
constexpr size_t WS_VSTAT = 33 * MiB, WS_HN = 40 * MiB, WS_HA = 72 * MiB, WS_HB = 136 * MiB;
constexpr size_t WS_WGU = 200 * MiB, WS_WD = 648 * MiB, WS_BIG = 872 * MiB;
constexpr size_t WS_U = WS_BIG, WS_V = WS_BIG + 96 * MiB, WS_S = WS_BIG + 192 * MiB;
constexpr size_t WS_HMOE = WS_BIG, WS_YSLOT = WS_BIG + 256 * MiB, WS_SLAB = WS_BIG + 400 * MiB;
constexpr size_t WS_PROJ = WS_BIG, WS_OLAT = WS_BIG, WS_QABS = WS_BIG + 128 * MiB, WS_SC = WS_BIG + 256 * MiB;
constexpr size_t WS_SEL = WS_BIG + 512 * MiB, WS_CKV = WS_BIG + 528 * MiB, WS_QI = WS_BIG + 536 * MiB, WS_KI = WS_BIG + 552 * MiB;
constexpr size_t WS_WI = WS_BIG + 554 * MiB, WS_O = WS_BIG + 556 * MiB, WS_END = WS_BIG + 588 * MiB;
static_assert((size_t)PMAX * DE * 2 <= 256 * MiB && (size_t)PMAX * D * 4 <= 144 * MiB, "moe buffers");
constexpr int CW_TMO = 0, CW_BAR = 4096, CW_CNT = 8192;

constexpr int RING_BYTES = 131072, MISC_OFF = 140 * 1024, LDS_BYTES = 163840;
constexpr int TAB_OFF = RING_BYTES;
constexpr int NWAVES = 8, NTHR = 512;

#define LDS_WAIT() asm volatile("s_waitcnt lgkmcnt(0)" ::: "memory")
#define VM_WAIT() asm volatile("s_waitcnt vmcnt(0)" ::: "memory")

typedef __bf16 bf16x2_t __attribute__((ext_vector_type(2)));
__device__ __forceinline__ unsigned cvt_pk_bf16(float lo, float hi) { const f32x2 v = {lo, hi}; const bf16x2_t b = __builtin_convertvector(v, bf16x2_t); return __builtin_bit_cast(unsigned, b); }
__device__ __forceinline__ float bf2f(unsigned short b) { return __builtin_bit_cast(float, ((unsigned)b) << 16); }
__device__ __forceinline__ float bflo(unsigned w) { return __builtin_bit_cast(float, w << 16); }
__device__ __forceinline__ float bfhi(unsigned w) { return __builtin_bit_cast(float, w & 0xffff0000u); }
__device__ __forceinline__ float wave_sum(float v) {
#pragma unroll
    for (int o = 1; o < 64; o <<= 1) v += __shfl_xor(v, o);
    return v;
}
__device__ __forceinline__ float fast_exp(float x) { return __builtin_amdgcn_exp2f(x * 1.44269504089f); }
__device__ __forceinline__ float sigmoidf_(float x) { return __builtin_amdgcn_rcpf(1.0f + fast_exp(-x)); }

#define XB_TMO      128
#define XB_XCNT(j)  (256  + 64 * (j))
#define XB_XSUB(j)  (1280 + 64 * (j))
#define XB_XGEN(j)  (2304 + 64 * (j))
#define XB_TOP      3328
#define XB_TOPGEN   3392
#define XCD_BAR_WORDS 3456
#define XB_SPIN_CAP (1u << 18)
__device__ __forceinline__ unsigned xb_ld(unsigned* p)              { return __hip_atomic_load(p, __ATOMIC_RELAXED, __HIP_MEMORY_SCOPE_AGENT); }
__device__ __forceinline__ unsigned xb_add(unsigned* p, unsigned v) { return __hip_atomic_fetch_add(p, v, __ATOMIC_RELAXED, __HIP_MEMORY_SCOPE_AGENT); }
__device__ __forceinline__ unsigned xb_xcc_id() { return (unsigned)__builtin_amdgcn_s_getreg((3 << 11) | 20) & 0xFu; }
#define XB_SPIN(cond, bar) do { unsigned _sp = 0; while (cond) { __builtin_amdgcn_s_sleep(1); \
    if ((++_sp & 255u) == 0u) { if (xb_ld(&(bar)[XB_TMO])) break; if (_sp > XB_SPIN_CAP) { atomicAdd(&(bar)[XB_TMO], 1u); break; } } } } while (0)
struct XcdBarrier { unsigned* bar; unsigned x; volatile LAS unsigned* st; };
__device__ __forceinline__ XcdBarrier xcd_barrier_post(unsigned* bar, volatile LAS unsigned* st) {
    XcdBarrier b; b.bar = bar; b.x = xb_xcc_id(); b.st = st;
    if (threadIdx.x == 0) (void)xb_add(&bar[XB_XCNT(b.x)], 1u);
    return b;
}
__device__ __forceinline__ void xcd_barrier_complete(unsigned* bar, unsigned x, unsigned& nloc, unsigned& nx) {
    const unsigned G = gridDim.x * gridDim.y * gridDim.z;
    unsigned sum, cnt, mine, sp = 0u;
    for (;;) {
        sum = 0u; cnt = 0u; mine = 0u;
#pragma unroll
        for (unsigned j = 0; j < 16; ++j) { const unsigned c = xb_ld(&bar[XB_XCNT(j)]); sum += c; cnt += (c > 0u) ? 1u : 0u; mine = (j == x) ? c : mine; }
        if (sum == G) break;
        __builtin_amdgcn_s_sleep(1);
        if ((++sp & 255u) == 0u) { if (xb_ld(&bar[XB_TMO])) break; if (sp > XB_SPIN_CAP) { atomicAdd(&bar[XB_TMO], 1u); break; } }
    }
    nloc = mine > 0u ? mine : 1u; nx = cnt > 0u ? cnt : 1u;
}
__device__ __forceinline__ void xcd_barrier(const XcdBarrier& b) {
    asm volatile("s_waitcnt vmcnt(0)" ::: "memory");
    __syncthreads();
    if (threadIdx.x == 0) {
        unsigned* bar = b.bar;
        __builtin_amdgcn_s_waitcnt(0);
        unsigned nloc = b.st[0], nx = b.st[1];
        if (nloc == 0u) { xcd_barrier_complete(bar, b.x, nloc, nx); b.st[0] = nloc; b.st[1] = nx; }
        const unsigned old = xb_add(&bar[XB_XSUB(b.x)], 1u);
        const unsigned gen = old / nloc;
        if (old + 1u == (gen + 1u) * nloc) {
            __builtin_amdgcn_fence(__ATOMIC_RELEASE, "agent");
            asm volatile("s_waitcnt vmcnt(0)" ::: "memory");
            const unsigned og = xb_add(&bar[XB_TOP], 1u);
            const unsigned tg = og / nx;
            if (og + 1u == (tg + 1u) * nx) xb_add(&bar[XB_TOPGEN], 1u);
            else XB_SPIN(xb_ld(&bar[XB_TOPGEN]) == tg, bar);
            __builtin_amdgcn_fence(__ATOMIC_ACQUIRE, "agent");
            xb_add(&bar[XB_XGEN(b.x)], 1u);
            asm volatile("s_waitcnt vmcnt(0)" ::: "memory");
        } else {
            XB_SPIN(xb_ld(&bar[XB_XGEN(b.x)]) == gen, bar);
            __builtin_amdgcn_fence(__ATOMIC_ACQUIRE, "agent");
            asm volatile("s_waitcnt vmcnt(0)" ::: "memory");
        }
    }
    __syncthreads();
}

namespace pg8 {
constexpr int BM = 256, BK = 64, HALF = 128, HTB = HALF * BK * 2, STAGE_BYTES = 8 * HTB, NXCD = 8, WGM = 8;
__device__ __forceinline__ int lds_byte(int r, int c) { const int st = (r >> 4) * 2 + (c >> 5), rr = r & 15, cc = c & 31, ob = rr * 64 + cc * 2; return st * 1024 + (ob ^ (((ob >> 9) & 1) << 5)); }
__device__ __forceinline__ void stage_rc(int b, int& R, int& C) { const int st = b / 1024, sb = b % 1024, swz = sb ^ (((sb >> 9) & 1) << 5); R = (st >> 1) * 16 + swz / 64; C = (st & 1) * 32 + (swz % 64) / 2; }
__device__ __forceinline__ int perm32(int rho) { const int n = rho >> 4, i = rho & 15; return 8 * (i >> 2) + 4 * n + (i & 3); }
__device__ __forceinline__ int xcd_remap(int wgid, int nwg) { const int q = nwg / NXCD, r = nwg % NXCD, xcd = wgid % NXCD, off = wgid / NXCD; return (xcd < r ? xcd * (q + 1) : r * (q + 1) + (xcd - r) * q) + off; }

struct Unit { int pm, pn, e, hrow, nvalid, lbase, kt0, nt, slab; };

struct DenseSched {
    const bf16* A; const bf16* Bt; int K, nM, nN, nwg, G, c;
    __device__ void init(const bf16* A_, const bf16* Bt_, int M_, int N_, int K_, int G_, int c_) { A = A_; Bt = Bt_; K = K_; nM = M_ / BM; nN = N_ / BM; nwg = nM * nN; G = G_; c = c_; }
    __device__ __forceinline__ bool next(int i, Unit& u) const {
        const long L = (long)i * G + c; if (L >= nwg) return false;
        const int wgid = xcd_remap((int)L, nwg);
        const int nig = WGM * nN, gid = wgid / nig, fm = gid * WGM, gsz = (nM - fm) < WGM ? (nM - fm) : WGM;
        u.pm = fm + ((wgid % nig) % gsz); u.pn = (wgid % nig) / gsz; u.e = 0; u.hrow = u.pm * BM; u.nvalid = BM; u.lbase = 0; u.kt0 = 0; u.nt = K / BK; u.slab = -1; return true;
    }
    __device__ __forceinline__ const char* a_base(const Unit& u) const { return (const char*)A + (size_t)u.pm * BM * K * 2; }
    __device__ __forceinline__ const char* b_base(const Unit& u) const { return (const char*)Bt + (size_t)u.pn * BM * K * 2; }
    __device__ __forceinline__ bool late() const { return false; }
    __device__ __forceinline__ void prefetch(const Unit&, int, int) const {}
    __device__ __forceinline__ void a_voff_late(const Unit&, const int (&)[2], const int (&)[2], unsigned (&)[2][2], int) const {}
    __device__ __forceinline__ void a_voff(const Unit&, const int (&R)[2], const int (&C)[2], unsigned (&v)[2][2]) const {
#pragma unroll
        for (int h = 0; h < 2; ++h)
#pragma unroll
            for (int i = 0; i < 2; ++i) v[h][i] = (unsigned)((h * HALF + R[i]) * K + C[i]) * 2u;
    }
};
struct MoeSched {
    const bf16* A; const bf16* Bt; const unsigned* list; const volatile LAS int* tab; int K, ncol, G, c; bool gather; size_t bstride;
    LAS unsigned* lbuf;
    bool ksplit;
    __device__ __forceinline__ int T(int i) const { return __builtin_amdgcn_readfirstlane(tab[i]); }
    __device__ __forceinline__ bool split_on(int nwg) const { return ksplit && G == 256 && nwg > 2 * G && nwg - 2 * G <= G / 4 && ((K / BK) % 8) == 0; }
    __device__ __forceinline__ void decode(int wgid, Unit& u) const {
        int e = 0;
#pragma unroll
        for (int j = 1; j < 16; ++j) e += (wgid >= T(j)) ? 1 : 0;
        const int local = wgid - T(e), tiles = T(17 + e);
        const int pn = local / tiles, rt = local % tiles;
        u.e = e; u.pn = pn; u.pm = rt; u.hrow = T(33 + e) + rt * BM; const int rem = T(49 + e) - rt * BM; u.nvalid = rem < BM ? rem : BM; u.lbase = rt * BM;
    }
    __device__ __forceinline__ bool next(int i, Unit& u) const {
        const int nwg = T(65); const int ntf = K / BK;
        int wgid, kt0 = 0, ntu = ntf, slab = -1;
        if (split_on(nwg)) {
            if (i > 2) return false;
            if (i < 2) wgid = xcd_remap(i * G + c, 2 * G);
            else { wgid = 2 * G + (c >> 2); if (wgid >= nwg) return false; ntu = ntf / 4; kt0 = (c & 3) * ntu; slab = c; }
        } else { const long L = (long)i * G + c; if (L >= nwg) return false; wgid = xcd_remap((int)L, nwg); }
        decode(wgid, u); u.kt0 = kt0; u.nt = ntu; u.slab = slab; return true;
    }
    __device__ __forceinline__ const char* a_base(const Unit& u) const { return (gather ? (const char*)A : (const char*)A + (size_t)u.hrow * K * 2) + (size_t)u.kt0 * (BK * 2); }
    __device__ __forceinline__ const char* b_base(const Unit& u) const { return (const char*)Bt + (size_t)u.e * bstride + (size_t)u.pn * BM * K * 2 + (size_t)u.kt0 * (BK * 2); }
    __device__ __forceinline__ bool late() const { return gather; }
    __device__ __forceinline__ void prefetch(const Unit& u, int slot, int lane) const {
        if (gather) __builtin_amdgcn_global_load_lds((const unsigned*)(list + (size_t)u.e * M + u.lbase + 4 * lane), (LAS unsigned*)(lbuf + slot * 256), 16, 0, 0); }
    __device__ __forceinline__ void a_voff_late(const Unit& u, const int (&R)[2], const int (&C)[2], unsigned (&v)[2][2], int slot) const {
#pragma unroll
        for (int h = 0; h < 2; ++h)
#pragma unroll
            for (int i = 0; i < 2; ++i) { const int r = h * HALF + R[i]; unsigned tok = lbuf[slot * 256 + r]; tok = r < u.nvalid ? tok : 0u; v[h][i] = (tok * (unsigned)K + (unsigned)C[i]) * 2u; } }
    __device__ __forceinline__ void a_voff(const Unit& u, const int (&R)[2], const int (&C)[2], unsigned (&v)[2][2]) const {
#pragma unroll
        for (int h = 0; h < 2; ++h)
#pragma unroll
            for (int i = 0; i < 2; ++i) {
                const int r = h * HALF + R[i];
                if (gather) { const int rc = r < u.nvalid ? r : u.nvalid - 1; unsigned tok = list[(size_t)u.e * M + u.lbase + rc]; tok = r < u.nvalid ? tok : 0u; v[h][i] = (tok * (unsigned)K + (unsigned)C[i]) * 2u; }
                else v[h][i] = (unsigned)(r * K + C[i]) * 2u;
            }
    }
};

template <class Epi, class Sched>
__device__ __forceinline__ void gemm_phase(LAS unsigned char* lds, const Sched& S, const Epi& E) {
    const int tid = threadIdx.x, wid = __builtin_amdgcn_readfirstlane(tid >> 6), lane = tid & 63, wr = wid >> 2, wc = wid & 3, fr = lane & 15, fq = lane >> 4;
    const int K = S.K; int nt = K / BK;
    int Rr[2], Cc[2]; unsigned voffB[2];
#pragma unroll
    for (int i = 0; i < 2; ++i) { int R, C; stage_rc(tid * 16 + i * 8192, R, C); Rr[i] = R; Cc[i] = C; const int Rb = Epi::PERM ? ((R & ~31) + perm32(R & 31)) : R; voffB[i] = (unsigned)(Rb * K + C) * 2u; }
    const size_t kstep = (size_t)(BK * 2);
    const size_t hstep = (size_t)HALF * K * 2;
    const unsigned ldsw = (unsigned)wid * 1024u;
    const int aoff = lds_byte(wr * 64 + fr, fq * 8), boff = lds_byte(wc * 32 + fr, fq * 8);
#define PG8_SA(b, h) (((b) * 2 + (h)) * HTB)
#define PG8_SB(b, h) ((4 + (b) * 2 + (h)) * HTB)
#define PG8_STAGE(bufoff, gbase, voff) do { _Pragma("unroll") for (int _i = 0; _i < 2; ++_i) \
        __builtin_amdgcn_global_load_lds((const unsigned*)((const char*)(gbase) + (voff)[_i]), (LAS unsigned*)(lds + (bufoff) + ldsw + _i * 8192), 16, 0, 0); } while (0)
#define PG8_LDA(dst, b, h) do { _Pragma("unroll") for (int m = 0; m < 4; ++m) _Pragma("unroll") for (int k = 0; k < 2; ++k) dst[m][k] = *(const LAS bf16x8*)(lds + PG8_SA(b, h) + aoff + m * 2048 + k * 1024); } while (0)
#define PG8_LDB(dst, b, h) do { _Pragma("unroll") for (int n = 0; n < 2; ++n) _Pragma("unroll") for (int k = 0; k < 2; ++k) dst[n][k] = *(const LAS bf16x8*)(lds + PG8_SB(b, h) + boff + n * 2048 + k * 1024); } while (0)
#define PG8_MMA(ai, bj, At, Bt) do { __builtin_amdgcn_s_setprio(1); _Pragma("unroll") for (int m = 0; m < 4; ++m) _Pragma("unroll") for (int n = 0; n < 2; ++n) _Pragma("unroll") for (int k = 0; k < 2; ++k) \
        acc[ai][bj][m][n] = __builtin_amdgcn_mfma_f32_16x16x32_bf16(Bt[n][k], At[m][k], acc[ai][bj][m][n], 0, 0, 0); __builtin_amdgcn_s_setprio(0); } while (0)
#define PG8_WAIT_V(n) asm volatile("s_waitcnt vmcnt(" #n ")" ::: "memory")
#define PG8_WAIT_L(n) asm volatile("s_waitcnt lgkmcnt(" #n ")" ::: "memory")
#define PG8_BAR __builtin_amdgcn_s_barrier()
#define PG8_SCHED __builtin_amdgcn_sched_barrier(0)
    Unit cur, nxt; int ui = 0;
    if (!S.next(0, cur)) return;
    f32x4 acc[2][2][4][2];
#pragma unroll
    for (int a = 0; a < 2; ++a)
#pragma unroll
        for (int b = 0; b < 2; ++b)
#pragma unroll
            for (int m = 0; m < 4; ++m)
#pragma unroll
                for (int n = 0; n < 2; ++n) acc[a][b][m][n] = (f32x4){0.f, 0.f, 0.f, 0.f};
    bf16x8 At[4][2], B0[2][2], B1[2][2];
    unsigned vc[2][2], vn[2][2];
    S.a_voff(cur, Rr, Cc, vc); nt = cur.nt;
    const char* cA = S.a_base(cur); const char* cB = S.b_base(cur);
    PG8_STAGE(PG8_SB(0, 0), cB, voffB); PG8_STAGE(PG8_SB(0, 1), cB + hstep, voffB); PG8_STAGE(PG8_SA(0, 0), cA, vc[0]); PG8_STAGE(PG8_SA(0, 1), cA, vc[1]);
    if (wr == 1) PG8_BAR;
    PG8_WAIT_V(2); PG8_BAR;
    PG8_STAGE(PG8_SB(1, 0), cB + kstep, voffB); PG8_STAGE(PG8_SA(1, 0), cA + kstep, vc[0]); PG8_STAGE(PG8_SB(1, 1), cB + hstep + kstep, voffB);
    PG8_WAIT_V(6); PG8_BAR;
    for (;;) {
        const bool has_next = S.next(ui + 1, nxt);
        const char* nA = has_next ? S.a_base(nxt) : cA; const char* nB = has_next ? S.b_base(nxt) : cB;
        if (has_next && S.late()) S.prefetch(nxt, ui & 1, lane);
        else if (has_next) S.a_voff(nxt, Rr, Cc, vn);
        else {
#pragma unroll
            for (int h = 0; h < 2; ++h)
#pragma unroll
                for (int i = 0; i < 2; ++i) vn[h][i] = vc[h][i]; }
        for (int t = 0; t < nt; t += 2) {
            const bool last = (t == nt - 2);
            const char* a1 = cA + (size_t)(t + 1) * kstep;
            const char* a2 = last ? nA : cA + (size_t)(t + 2) * kstep; const char* b2 = last ? nB : cB + (size_t)(t + 2) * kstep;
            const char* a3 = a2 + kstep; const char* b3 = b2 + kstep;
            if (last && has_next && S.late()) S.a_voff_late(nxt, Rr, Cc, vn, ui & 1);
            unsigned vx[2][2];
#pragma unroll
            for (int h = 0; h < 2; ++h)
#pragma unroll
                for (int i = 0; i < 2; ++i) vx[h][i] = last ? vn[h][i] : vc[h][i];
            PG8_LDB(B0, 0, 0); PG8_LDB(B1, 0, 1); PG8_SCHED; PG8_LDA(At, 0, 0); PG8_STAGE(PG8_SA(1, 1), a1, vc[1]);
            PG8_WAIT_V(8); PG8_WAIT_L(0); PG8_BAR; PG8_MMA(0, 0, At, B0); PG8_MMA(0, 1, At, B1); PG8_BAR; PG8_SCHED;
            PG8_LDA(At, 0, 1); PG8_STAGE(PG8_SB(0, 0), b2, voffB); PG8_STAGE(PG8_SB(0, 1), b2 + hstep, voffB); PG8_STAGE(PG8_SA(0, 0), a2, vx[0]);
            PG8_WAIT_V(8); PG8_WAIT_L(0); PG8_BAR; PG8_MMA(1, 0, At, B0); PG8_MMA(1, 1, At, B1); PG8_BAR; PG8_SCHED;
            PG8_LDB(B0, 1, 0); PG8_LDB(B1, 1, 1); PG8_SCHED; PG8_LDA(At, 1, 0); PG8_STAGE(PG8_SA(0, 1), a2, vx[1]);
            PG8_WAIT_V(8); PG8_WAIT_L(0); PG8_BAR; PG8_MMA(0, 0, At, B0); PG8_MMA(0, 1, At, B1); PG8_BAR; PG8_SCHED;
            PG8_LDA(At, 1, 1); PG8_STAGE(PG8_SB(1, 0), b3, voffB); PG8_STAGE(PG8_SB(1, 1), b3 + hstep, voffB); PG8_STAGE(PG8_SA(1, 0), a3, vx[0]);
            PG8_WAIT_V(8); PG8_WAIT_L(0); PG8_BAR; PG8_MMA(1, 0, At, B0); PG8_MMA(1, 1, At, B1); PG8_BAR; PG8_SCHED;
        }
        if (wr == 0) PG8_BAR;
        E(acc, cur, wr, wc, fr, fq);
        if (!has_next) break;
#pragma unroll
        for (int a = 0; a < 2; ++a)
#pragma unroll
            for (int b = 0; b < 2; ++b)
#pragma unroll
                for (int m = 0; m < 4; ++m)
#pragma unroll
                    for (int n = 0; n < 2; ++n) acc[a][b][m][n] = (f32x4){0.f, 0.f, 0.f, 0.f};
        cur = nxt; cA = nA; cB = nB; ++ui; nt = cur.nt;
#pragma unroll
        for (int h = 0; h < 2; ++h)
#pragma unroll
            for (int i = 0; i < 2; ++i) vc[h][i] = vn[h][i];
        if (wr == 1) PG8_BAR;
    }
    PG8_WAIT_V(0);
    PG8_BAR;
#undef PG8_SA
#undef PG8_SB
#undef PG8_STAGE
#undef PG8_LDA
#undef PG8_LDB
#undef PG8_MMA
#undef PG8_WAIT_V
#undef PG8_WAIT_L
#undef PG8_BAR
#undef PG8_SCHED
}

__device__ __forceinline__ float gelu_tanh(float x) { const float y = 1.5957691216f * (x + 0.044715f * x * x * x); return x * __builtin_amdgcn_rcpf(1.0f + __builtin_amdgcn_exp2f(-1.44269504089f * y)); }
struct EpiGeluUV {
    static constexpr bool PERM = true;
    bf16* U; bf16* V; f32x2* vstat;
    __device__ __forceinline__ void operator()(const f32x4 (&acc)[2][2][4][2], const Unit& u, int wr, int wc, int fr, int fq) const {
        const bool isv = u.pn >= 12; const int ct = isv ? u.pn - 12 : u.pn;
        bf16* base = isv ? V : U;
        const int row0 = u.pm * BM + wr * 64 + fr, col0 = ct * BM + wc * 32 + 8 * fq;
#pragma unroll
        for (int ai = 0; ai < 2; ++ai)
#pragma unroll
            for (int m = 0; m < 4; ++m) { const int row = row0 + ai * HALF + m * 16; bf16* rowp = base + (size_t)row * AIN + col0; float s1 = 0.f, s2 = 0.f;
#pragma unroll
                for (int bj = 0; bj < 2; ++bj) { f32x4 v0 = acc[ai][bj][m][0], v1 = acc[ai][bj][m][1];
#pragma unroll
                    for (int j = 0; j < 4; ++j) { v0[j] = gelu_tanh(v0[j]); v1[j] = gelu_tanh(v1[j]); s1 += v0[j] + v1[j]; s2 += v0[j] * v0[j] + v1[j] * v1[j]; }
                    u32x4 w; w.x = cvt_pk_bf16(v0[0], v0[1]); w.y = cvt_pk_bf16(v0[2], v0[3]); w.z = cvt_pk_bf16(v1[0], v1[1]); w.w = cvt_pk_bf16(v1[2], v1[3]);
                    *(u32x4*)(rowp + bj * HALF) = w; }
                if (isv) { s1 += __shfl_xor(s1, 16); s1 += __shfl_xor(s1, 32); s2 += __shfl_xor(s2, 16); s2 += __shfl_xor(s2, 32);
                    if (fq == 0) vstat[(size_t)row * 48 + ct * 4 + wc] = (f32x2){s1, s2}; } }
    }
};
struct EpiResid {
    static constexpr bool PERM = false;
    const float* base; float* out; const float* gate;
    __device__ __forceinline__ void operator()(const f32x4 (&acc)[2][2][4][2], const Unit& u, int wr, int wc, int fr, int fq) const {
        const int row0 = u.pm * BM + wr * 64 + fr, col0 = u.pn * BM + wc * 32 + 4 * fq; const int b = (u.pm * BM) / SEQ;
        f32x4 gv[2][2];
#pragma unroll
        for (int bj = 0; bj < 2; ++bj)
#pragma unroll
            for (int n = 0; n < 2; ++n) gv[bj][n] = *(const f32x4*)(gate + b * 6144 + col0 + bj * HALF + n * 16);
#pragma unroll
        for (int ai = 0; ai < 2; ++ai)
#pragma unroll
            for (int m = 0; m < 4; m += 2) { const size_t off = (size_t)(row0 + ai * HALF + m * 16) * D + col0;
                f32x4 bs[2][2][2];
#pragma unroll
                for (int mm = 0; mm < 2; ++mm)
#pragma unroll
                    for (int bj = 0; bj < 2; ++bj)
#pragma unroll
                        for (int n = 0; n < 2; ++n) bs[mm][bj][n] = *(const f32x4*)(base + off + (size_t)mm * 16 * D + bj * HALF + n * 16);
#pragma unroll
                for (int mm = 0; mm < 2; ++mm)
#pragma unroll
                    for (int bj = 0; bj < 2; ++bj)
#pragma unroll
                        for (int n = 0; n < 2; ++n) *(f32x4*)(out + off + (size_t)mm * 16 * D + bj * HALF + n * 16) = bs[mm][bj][n] + gv[bj][n] * acc[ai][bj][m + mm][n]; }
    }
};
struct EpiF32 {
    static constexpr bool PERM = false;
    float* C; int ldc; float* slabs;
    __device__ __forceinline__ void operator()(const f32x4 (&acc)[2][2][4][2], const Unit& u, int wr, int wc, int fr, int fq) const {
        const bool sp = u.slab >= 0;
        const int row0 = (sp ? 0 : u.hrow) + wr * 64 + fr, col0 = (sp ? 0 : u.pn * BM) + wc * 32 + 4 * fq; const int ld = sp ? BM : ldc;
        float* base = sp ? slabs + (size_t)u.slab * (BM * BM) : C;
#pragma unroll
        for (int ai = 0; ai < 2; ++ai)
#pragma unroll
            for (int m = 0; m < 4; ++m) { float* rowp = base + (size_t)(row0 + ai * HALF + m * 16) * ld + col0;
#pragma unroll
                for (int bj = 0; bj < 2; ++bj)
#pragma unroll
                    for (int n = 0; n < 2; ++n) *(f32x4*)(rowp + bj * HALF + n * 16) = acc[ai][bj][m][n]; }
    }
};
struct EpiSwiGLU {
    static constexpr bool PERM = true;
    bf16* H;
    __device__ __forceinline__ void operator()(const f32x4 (&acc)[2][2][4][2], const Unit& u, int wr, int wc, int fr, int fq) const {
        const int row0 = u.hrow + wr * 64 + fr, col0 = u.pn * HALF + wc * 32 + 8 * fq;
#pragma unroll
        for (int ai = 0; ai < 2; ++ai)
#pragma unroll
            for (int m = 0; m < 4; ++m) { bf16* rowp = H + (size_t)(row0 + ai * HALF + m * 16) * DE + col0;
                f32x4 v0, v1;
#pragma unroll
                for (int j = 0; j < 4; ++j) { const float g0 = acc[ai][0][m][0][j], g1 = acc[ai][0][m][1][j];
                    v0[j] = g0 * sigmoidf_(g0) * acc[ai][1][m][0][j]; v1[j] = g1 * sigmoidf_(g1) * acc[ai][1][m][1][j]; }
                u32x4 w; w.x = cvt_pk_bf16(v0[0], v0[1]); w.y = cvt_pk_bf16(v0[2], v0[3]); w.z = cvt_pk_bf16(v1[0], v1[1]); w.w = cvt_pk_bf16(v1[2], v1[3]);
                *(u32x4*)rowp = w; }
    }
};
struct EpiYbf {
    static constexpr bool PERM = true;
    bf16* Y; bf16* slabs;
    __device__ __forceinline__ void operator()(const f32x4 (&acc)[2][2][4][2], const Unit& u, int wr, int wc, int fr, int fq) const {
        const bool sp = u.slab >= 0;
        bf16* base = sp ? slabs + (size_t)u.slab * (BM * BM) : Y + (size_t)u.hrow * D + u.pn * BM;
        const int ld = sp ? BM : D;
        base += (size_t)(wr * 64 + fr) * ld + wc * 32 + 8 * fq;
#pragma unroll
        for (int ai = 0; ai < 2; ++ai)
#pragma unroll
            for (int m = 0; m < 4; ++m) { bf16* rowp = base + (size_t)(ai * HALF + m * 16) * ld;
#pragma unroll
                for (int bj = 0; bj < 2; ++bj) { const f32x4 v0 = acc[ai][bj][m][0], v1 = acc[ai][bj][m][1];
                    *(u32x4*)(rowp + bj * HALF) = (u32x4){cvt_pk_bf16(v0[0], v0[1]), cvt_pk_bf16(v0[2], v0[3]), cvt_pk_bf16(v1[0], v1[1]), cvt_pk_bf16(v1[2], v1[3])}; } }
    }
};
}

struct Args { const float* in[25]; float* out; unsigned char* ws; int ph_lo, ph_hi; };
enum { I_X = 0, I_C, I_ADAW, I_ADAB, I_N1G, I_N2G, I_AWIN, I_ALNG, I_ALNB, I_AWSP, I_ABSP, I_AWOUT, I_BWIN, I_BKVG, I_BWUK, I_BWUV, I_BKIG, I_BWOUT, I_RELB, I_RW, I_RB, I_WG, I_WU, I_WDN, I_FG };

__device__ __forceinline__ unsigned f2bf(float f) { unsigned u = __builtin_bit_cast(unsigned, f); return (u + 0x7fffu + ((u >> 16) & 1u)) >> 16; }
__device__ __forceinline__ unsigned pk2(float lo, float hi) { return f2bf(lo) | (f2bf(hi) << 16); }
template <bool NT = false, class DRow>
__device__ __forceinline__ void transpose_item(const float* W, int K, int N, bf16* WT, LAS float* scr, int item, int nblk, int lane, DRow drow) {
    const int kb = item / nblk, nb = item % nblk, k0 = 64 * kb, n0 = 32 * nb;
    const int nn = n0 + (lane & 31); const bool ok = nn < N;
    if constexpr (NT) {
#pragma unroll 8
    for (int i = 0; i < 32; ++i) { const int kk = 2 * i + (lane >> 5); scr[kk * 33 + (lane & 31)] = ok ? (NT ? __builtin_nontemporal_load(W + (size_t)(k0 + kk) * N + nn) : W[(size_t)(k0 + kk) * N + nn]) : 0.f; }
    } else {
#pragma unroll
    for (int i = 0; i < 32; ++i) { const int kk = 2 * i + (lane >> 5); scr[kk * 33 + (lane & 31)] = ok ? (NT ? __builtin_nontemporal_load(W + (size_t)(k0 + kk) * N + nn) : W[(size_t)(k0 + kk) * N + nn]) : 0.f; }
    }
    LDS_WAIT(); asm volatile("" ::: "memory");
    const int c = lane & 7;
#pragma unroll
    for (int j = 0; j < 4; ++j) { const int n = (lane >> 3) + 8 * j; const LAS float* s = scr + (8 * c) * 33 + n;
        u32x4 o; o.x = pk2(s[0 * 33], s[1 * 33]); o.y = pk2(s[2 * 33], s[3 * 33]); o.z = pk2(s[4 * 33], s[5 * 33]); o.w = pk2(s[6 * 33], s[7 * 33]);
        if (NT) __builtin_nontemporal_store(o, (GAS u32x4*)(WT + (size_t)drow(n0 + n) * K + k0 + 8 * c)); else *(GAS u32x4*)(WT + (size_t)drow(n0 + n) * K + k0 + 8 * c) = o; }
    LDS_WAIT(); asm volatile("" ::: "memory");
}
template <bool NT>
__device__ __forceinline__ void moe_transpose(const Args& a, LAS float* scr, int idx, int layer, int lane) {
    unsigned char* ws = a.ws; const int mat = idx / 1792, item = idx % 1792, which = mat >> 4, le = layer * 16 + (mat & 15);
    if (which == 0) transpose_item<NT>(a.in[I_WG] + (size_t)le * D * DE, D, DE, (bf16*)(ws + WS_WGU) + (size_t)le * NGU * D, scr, item, DE / 32, lane, [](int n) { return (n >> 7) * 256 + (n & 127); });
    else if (which == 1) transpose_item<NT>(a.in[I_WU] + (size_t)le * D * DE, D, DE, (bf16*)(ws + WS_WGU) + (size_t)le * NGU * D, scr, item, DE / 32, lane, [](int n) { return (n >> 7) * 256 + 128 + (n & 127); });
    else transpose_item<NT>(a.in[I_WDN] + (size_t)le * DE * D, DE, D, (bf16*)(ws + WS_WD) + (size_t)le * D * DE, scr, item, D / 32, lane, [](int n) { return n; });
}
__device__ __forceinline__ void p0_prologue(const Args& a, LAS unsigned char* lds, int gw, int NGW, int wave, int lane) {
    unsigned char* ws = a.ws;
    LAS float* scr = (LAS float*)(lds + wave * 16384);
    for (int it = gw; it < 2 * 96 * 8; it += NGW) {
        const int ks = it & 7, cc = (it >> 3) % 96, l = it / 768, k0 = ks * 128, col = cc * 64 + lane;
#pragma unroll
        for (int b = 0; b < 4; ++b)
#pragma unroll
            for (int j = 0; j < 2; ++j) { const float v = a.in[I_C][b * D + k0 + j * 64 + lane]; scr[b * 128 + j * 64 + lane] = v * sigmoidf_(v); }
        LDS_WAIT(); asm volatile("" ::: "memory");
        const float* W = a.in[I_ADAW] + ((size_t)l * D + k0) * 6144 + col;
        float a0 = 0.f, a1 = 0.f, a2 = 0.f, a3 = 0.f;
#pragma unroll
        for (int h = 0; h < 2; ++h) {
            float wv[64];
#pragma unroll
            for (int k = 0; k < 64; ++k) wv[k] = W[(size_t)(h * 64 + k) * 6144];
            __builtin_amdgcn_sched_barrier(0);
#pragma unroll
            for (int k = 0; k < 64; ++k) { const int kk = h * 64 + k; const float w = wv[k]; a0 += scr[kk] * w; a1 += scr[128 + kk] * w; a2 += scr[256 + kk] * w; a3 += scr[384 + kk] * w; }
            __builtin_amdgcn_sched_barrier(0);
        }
        float* mp = (float*)(ws + WS_MODP) + (size_t)ks * 49152 + (size_t)l * 24576 + col;
        mp[0] = a0; mp[6144] = a1; mp[2 * 6144] = a2; mp[3 * 6144] = a3;
        LDS_WAIT(); asm volatile("" ::: "memory");
    }
    {
        const int gt = gw * 64 + lane, NT = NGW * 64;
        bf16* wuk = (bf16*)(ws + WS_WUK); bf16* wuvt = (bf16*)(ws + WS_WUVT); bf16* wsp = (bf16*)(ws + WS_WSP);
        for (int i = gt; i < CL * NH * HD; i += NT) wuk[i] = (bf16)f2bf(a.in[I_BWUK][i]);
        for (int i = gt; i < CL * NH * HD; i += NT) { const int c = i & 255, d = (i >> 8) & 63, h = i >> 14; wuvt[i] = (bf16)f2bf(a.in[I_BWUV][(c * NH + h) * HD + d]); }
        for (int i = gt; i < NGRP * CHUNK * CHUNK; i += NT) { const int s = i & 127, t = (i >> 7) & 127; wsp[i] = (s <= t) ? (bf16)f2bf(a.in[I_AWSP][i]) : (bf16)0; }
    }
    constexpr int I_A1 = 16 * 192, I_A2 = 48 * 32, I_B1 = 16 * 64, I_B2 = 16 * 32, I_M = 1792;
    constexpr int NSMALL = I_A1 + I_A2 + I_B1 + I_B2;
    const int NITEMS = NSMALL;
    for (int it = gw; it < NITEMS; it += NGW) {
        int r = it;
        if (r < I_A1) { transpose_item(a.in[I_AWIN], D, NZ, (bf16*)(ws + WS_WINA), scr, r, NZ / 32, lane, [](int n) { return n; }); continue; } r -= I_A1;
        if (r < I_A2) { transpose_item(a.in[I_AWOUT], AIN, D, (bf16*)(ws + WS_WOUTA), scr, r, D / 32, lane, [](int n) { return n; }); continue; } r -= I_A2;
        if (r < I_B1) { transpose_item(a.in[I_BWIN], D, BPROJ, (bf16*)(ws + WS_WINB), scr, r, NPROJ / 32, lane, [](int n) { return n; }); continue; } r -= I_B1;
        if (r < I_B2) { transpose_item(a.in[I_BWOUT], D, D, (bf16*)(ws + WS_WOUTB), scr, r, D / 32, lane, [](int n) { return n; }); continue; } r -= I_B2;
        moe_transpose<false>(a, scr, r, 0, lane);
    }
}

__device__ __forceinline__ float mod_val(const Args& a, bool partials, int l, int b, int j) {
    if (!partials) return ((const float*)(a.ws + WS_MODF))[(l * 4 + b) * 6144 + j];
    float s = a.in[I_ADAB][l * 6144 + j]; const float* mp = (const float*)(a.ws + WS_MODP) + (size_t)(l * 4 + b) * 6144 + j;
#pragma unroll
    for (int ks = 0; ks < 8; ++ks) s += mp[(size_t)ks * 49152];
    return s;
}
__device__ __forceinline__ void load_norm_vecs(const Args& a, bool partials, int l, int b, int shift_part, const float* g, LAS float* vsc, LAS float* vsh) {
    for (int d = threadIdx.x; d < D; d += NTHR) { vsc[d] = g[d] * (1.0f + mod_val(a, partials, l, b, (shift_part + 1) * 1024 + d)); vsh[d] = mod_val(a, partials, l, b, shift_part * 1024 + d); }
}
__device__ __forceinline__ void rms_mod_row(f32x4 (&v)[4], const LAS float* vsc, const LAS float* vsh, int lane) {
    float s = 0.f;
#pragma unroll
    for (int j = 0; j < 4; ++j) s += (v[j].x * v[j].x + v[j].y * v[j].y) + (v[j].z * v[j].z + v[j].w * v[j].w);
    const float rstd = 1.0f / sqrtf(wave_sum(s) * (1.0f / D) + EPS);
#pragma unroll
    for (int j = 0; j < 4; ++j) { const f32x4 c = *(const LAS f32x4*)(vsc + 4 * lane + 256 * j), h = *(const LAS f32x4*)(vsh + 4 * lane + 256 * j); v[j] = v[j] * rstd * c + h; }
}
__device__ __forceinline__ void store_row_bf16(const f32x4 (&v)[4], bf16* orow, int lane) {
    GAS u32x2* o8 = (GAS u32x2*)orow + lane;
#pragma unroll
    for (int j = 0; j < 4; ++j) o8[64 * j] = (u32x2){cvt_pk_bf16(v[j].x, v[j].y), cvt_pk_bf16(v[j].z, v[j].w)};
}

__device__ __forceinline__ bf16x4 lds_tr16(const LAS unsigned char* p) { return __builtin_bit_cast(bf16x4, __builtin_amdgcn_ds_read_tr16_b64_v4i16((LAS v4i16_t*)p)); }
constexpr int SG_STRIDE = 800;
struct CvItem { const float* src; bf16* dst; int N, K, n0, radd; bool plain; };
__device__ __forceinline__ CvItem cv_item(const Args& a, int idx, int layer) {
    unsigned char* ws = a.ws; const int mat = idx / 1792, item = idx % 1792, which = mat >> 4, le = layer * 16 + (mat & 15);
    CvItem c;
    if (which == 2) { const int kb = item >> 5, nb = item & 31; c.N = D; c.K = DE; c.n0 = 32 * nb; c.src = a.in[I_WDN] + (size_t)le * DE * D + (size_t)(64 * kb) * D + c.n0; c.dst = (bf16*)(ws + WS_WD) + (size_t)le * D * DE + 64 * kb; c.plain = true; c.radd = 0; }
    else { const int kb = item / 112, nb = item % 112; c.N = DE; c.K = D; c.n0 = 32 * nb; c.src = (which ? a.in[I_WU] : a.in[I_WG]) + (size_t)le * D * DE + (size_t)(64 * kb) * DE + c.n0; c.dst = (bf16*)(ws + WS_WGU) + (size_t)le * NGU * D + 64 * kb; c.plain = false; c.radd = which ? 128 : 0; }
    return c;
}
__device__ __forceinline__ void cv_load(const CvItem& c, int lane, float (&r)[32]) {
#pragma unroll
    for (int i = 0; i < 32; ++i) { const unsigned off = (unsigned)(((2 * i + (lane >> 5)) * c.N + (lane & 31)) * 4); r[i] = __builtin_nontemporal_load((const float*)((const char*)c.src + off)); }
}
__device__ __forceinline__ void cv_finish(const CvItem& c, LAS float* scr, int lane, const float (&r)[32]) {
    unsigned d[16];
#pragma unroll
    for (int m = 0; m < 16; ++m) {
        const auto sw = __builtin_amdgcn_permlane32_swap(__builtin_bit_cast(unsigned, r[m]), __builtin_bit_cast(unsigned, r[16 + m]), false, false);
        d[m] = cvt_pk_bf16(__builtin_bit_cast(float, (unsigned)sw[0]), __builtin_bit_cast(float, (unsigned)sw[1]));
    }
    LAS unsigned char* sb = (LAS unsigned char*)scr;
    LAS u32x4* wp = (LAS u32x4*)(sb + (lane & 31) * 144 + (lane >> 5) * 64);
#pragma unroll
    for (int q = 0; q < 4; ++q) wp[q] = (u32x4){d[4 * q], d[4 * q + 1], d[4 * q + 2], d[4 * q + 3]};
    LDS_WAIT(); asm volatile("" ::: "memory");
    const int c8 = lane & 7;
#pragma unroll
    for (int j = 0; j < 4; ++j) { const int n = (lane >> 3) + 8 * j;
        const u32x4 o = *(const LAS u32x4*)(sb + n * 144 + c8 * 16);
        const int nn = c.n0 + n, dr = c.plain ? nn : (nn >> 7) * 256 + c.radd + (nn & 127);
        __builtin_nontemporal_store(o, (GAS u32x4*)(c.dst + (size_t)dr * c.K + 8 * c8)); }
    LDS_WAIT(); asm volatile("" ::: "memory");
}
__device__ __forceinline__ void cv_batch3(const Args& a, LAS float* scr, int idx0, int stride, int layer, int lane) {
    const int total = 3 * 16 * 1792;
    if (idx0 + 2 * stride < total) {
        const CvItem c0 = cv_item(a, idx0, layer), c1 = cv_item(a, idx0 + stride, layer), c2 = cv_item(a, idx0 + 2 * stride, layer);
        float R0[32], R1[32], R2[32];
        __builtin_amdgcn_sched_barrier(0);
        cv_load(c0, lane, R0); cv_load(c1, lane, R1); cv_load(c2, lane, R2);
        __builtin_amdgcn_sched_barrier(0);
        cv_finish(c0, scr, lane, R0); cv_finish(c1, scr, lane, R1); cv_finish(c2, scr, lane, R2);
    } else {
#pragma unroll 1
        for (int k = 0; k < 3; ++k) { const int idx = idx0 + k * stride; if (idx < total) { const CvItem c0 = cv_item(a, idx, layer); float R0[32]; cv_load(c0, lane, R0); cv_finish(c0, scr, lane, R0); } }
    }
}
__device__ __forceinline__ CvItem cv64_item(const Args& a, int idx, int layer) {
    unsigned char* ws = a.ws; const int mat = idx / 896, item = idx % 896, which = mat >> 4, le = layer * 16 + (mat & 15);
    CvItem c;
    if (which == 2) { const int kb = item >> 4, nb = item & 15; c.N = D; c.K = DE; c.n0 = 64 * nb; c.src = a.in[I_WDN] + (size_t)le * DE * D + (size_t)(64 * kb) * D + c.n0; c.dst = (bf16*)(ws + WS_WD) + (size_t)le * D * DE + 64 * kb; c.plain = true; c.radd = 0; }
    else { const int kb = item / 56, nb = item % 56; c.N = DE; c.K = D; c.n0 = 64 * nb; c.src = (which ? a.in[I_WU] : a.in[I_WG]) + (size_t)le * D * DE + (size_t)(64 * kb) * DE + c.n0; c.dst = (bf16*)(ws + WS_WGU) + (size_t)le * NGU * D + 64 * kb; c.plain = false; c.radd = which ? 128 : 0; }
    return c;
}
__device__ __forceinline__ void cv64_load(const CvItem& c, int lane, float (&r)[64]) {
#pragma unroll
    for (int i = 0; i < 64; ++i) { const unsigned off = (unsigned)((i * c.N + lane) * 4); r[i] = __builtin_nontemporal_load((const float*)((const char*)c.src + off)); }
}
__device__ __forceinline__ void cv64_finish(const CvItem& c, LAS float* scr, int lane, const float (&r)[64]) {
    LAS unsigned char* sb = (LAS unsigned char*)scr;
    LAS u32x4* wp = (LAS u32x4*)(sb + lane * 144);
#pragma unroll
    for (int q = 0; q < 8; ++q) wp[q] = (u32x4){cvt_pk_bf16(r[8 * q], r[8 * q + 1]), cvt_pk_bf16(r[8 * q + 2], r[8 * q + 3]), cvt_pk_bf16(r[8 * q + 4], r[8 * q + 5]), cvt_pk_bf16(r[8 * q + 6], r[8 * q + 7])};
    LDS_WAIT(); asm volatile("" ::: "memory");
    const int c8 = lane & 7;
#pragma unroll
    for (int j = 0; j < 8; ++j) { const int n = (lane >> 3) + 8 * j;
        const u32x4 o = *(const LAS u32x4*)(sb + n * 144 + c8 * 16);
        const int nn = c.n0 + n, dr = c.plain ? nn : (nn >> 7) * 256 + c.radd + (nn & 127);
        __builtin_nontemporal_store(o, (GAS u32x4*)(c.dst + (size_t)dr * c.K + 8 * c8)); }
    LDS_WAIT(); asm volatile("" ::: "memory");
}
__device__ __forceinline__ void cv64_batch3(const Args& a, LAS float* scr, int idx0, int stride, int layer, int lane) {
    const int total = 3 * 16 * 896;
    if (idx0 + 2 * stride < total) {
        const CvItem c0 = cv64_item(a, idx0, layer), c1 = cv64_item(a, idx0 + stride, layer), c2 = cv64_item(a, idx0 + 2 * stride, layer);
        { float R0[64], R1[64];
          __builtin_amdgcn_sched_barrier(0);
          cv64_load(c0, lane, R0); cv64_load(c1, lane, R1);
          __builtin_amdgcn_sched_barrier(0);
          cv64_finish(c0, scr, lane, R0); cv64_finish(c1, scr, lane, R1); }
        __builtin_amdgcn_sched_barrier(0);
        { float R2[64]; cv64_load(c2, lane, R2); cv64_finish(c2, scr, lane, R2); }
    } else {
#pragma unroll 1
        for (int k = 0; k < 3; ++k) { const int idx = idx0 + k * stride; if (idx < total) { const CvItem c0 = cv64_item(a, idx, layer); float R0[64]; cv64_load(c0, lane, R0); cv64_finish(c0, scr, lane, R0); } }
    }
}
__device__ __forceinline__ void spatial_phase(const Args& a, LAS unsigned char* lds, int G, int vcu) {
    const int tid = threadIdx.x, lane = tid & 63, wid = __builtin_amdgcn_readfirstlane(tid >> 6), fr = lane & 15, fq = lane >> 4;
    unsigned char* ws = a.ws;
    const bf16* U = (const bf16*)(ws + WS_U); const bf16* V = (const bf16*)(ws + WS_V); bf16* S = (bf16*)(ws + WS_S);
    const f32x2* vstat = (const f32x2*)(ws + WS_VSTAT); const bf16* wsp = (const bf16*)(ws + WS_WSP);
    LAS unsigned char* vt = lds;
    LAS float* mu = (LAS float*)(lds + 102400); LAS float* rs = mu + 128;
    LAS float* lg = rs + 128; LAS float* lb = lg + GW;
    for (int unit = vcu; unit < 128 * NGRP; unit += G) {
        const int grp = unit & 7, chunk = unit >> 3, row0 = chunk * CHUNK, c0 = grp * GW;
        __syncthreads();
        if (tid < 128) { const GAS f32x4* p4 = (const GAS f32x4*)(vstat + (size_t)(row0 + tid) * 48); float s1 = 0.f, s2 = 0.f;
            f32x4 q4[24];
#pragma unroll
            for (int j = 0; j < 24; ++j) q4[j] = p4[j];
#pragma unroll
            for (int j = 0; j < 24; ++j) { s1 += q4[j].x + q4[j].z; s2 += q4[j].y + q4[j].w; }
            const float m = s1 * (1.0f / AIN), var = s2 * (1.0f / AIN) - m * m; mu[tid] = m; rs[tid] = 1.0f / sqrtf(fmaxf(var, 0.f) + EPS); }
        for (int i = tid; i < GW; i += NTHR) { lg[i] = a.in[I_ALNG][c0 + i]; lb[i] = a.in[I_ALNB][c0 + i]; }
        __syncthreads();
        bf16x8 Yf[20];
#pragma unroll
        for (int ks = 0; ks < 4; ++ks)
#pragma unroll
            for (int mt = 2 * ks; mt < 8; ++mt) Yf[(ks == 0 ? 0 : ks == 1 ? 8 : ks == 2 ? 14 : 18) + mt - 2 * ks] = *(const GAS bf16x8*)(wsp + ((size_t)grp * CHUNK + 16 * mt + fr) * CHUNK + 32 * ks + 8 * fq);
#pragma unroll 1
        for (int i0 = 0; i0 < 12; i0 += 6) {
        u32x4 rawv[6];
#pragma unroll
        for (int i = 0; i < 6; ++i) { const int ch = tid + (i0 + i) * NTHR, s = ch / 48, cc = ch % 48; rawv[i] = *(const GAS u32x4*)(V + (size_t)(row0 + s) * AIN + c0 + cc * 8); }
#pragma unroll
        for (int i = 0; i < 6; ++i) { const int ch = tid + (i0 + i) * NTHR, s = ch / 48, cc = ch % 48;
            const u32x4 raw = rawv[i];
            const float m = mu[s], r = rs[s]; const LAS float* g8 = lg + cc * 8; const LAS float* b8 = lb + cc * 8;
            float x[8] = {bflo(raw.x), bfhi(raw.x), bflo(raw.y), bfhi(raw.y), bflo(raw.z), bfhi(raw.z), bflo(raw.w), bfhi(raw.w)};
#pragma unroll
            for (int j = 0; j < 8; ++j) x[j] = (x[j] - m) * r * g8[j] + b8[j];
            u32x4 w; w.x = cvt_pk_bf16(x[0], x[1]); w.y = cvt_pk_bf16(x[2], x[3]); w.z = cvt_pk_bf16(x[4], x[5]); w.w = cvt_pk_bf16(x[6], x[7]);
            *(LAS u32x4*)(vt + s * SG_STRIDE + cc * 16) = w; }
        }
        __syncthreads();
        f32x4 acc[8][3];
#pragma unroll
        for (int mt = 0; mt < 8; ++mt)
#pragma unroll
            for (int n = 0; n < 3; ++n) acc[mt][n] = (f32x4){0.f, 0.f, 0.f, 0.f};
        const int q = fr >> 2, p = fr & 3;
#pragma unroll
        for (int ks = 0; ks < 4; ++ks) {
            bf16x8 X[3];
#pragma unroll
            for (int n = 0; n < 3; ++n) { const LAS unsigned char* bp = vt + (32 * ks + 8 * fq + q) * SG_STRIDE + (48 * wid + 16 * n + 4 * p) * 2;
                const bf16x4 lo = lds_tr16(bp), hi = lds_tr16(bp + 4 * SG_STRIDE);
                X[n] = (bf16x8){lo[0], lo[1], lo[2], lo[3], hi[0], hi[1], hi[2], hi[3]}; }
#pragma unroll
            for (int mt = 2 * ks; mt < 8; ++mt) {
                const bf16x8 Y = Yf[(ks == 0 ? 0 : ks == 1 ? 8 : ks == 2 ? 14 : 18) + mt - 2 * ks];
#pragma unroll
                for (int n = 0; n < 3; ++n) acc[mt][n] = __builtin_amdgcn_mfma_f32_16x16x32_bf16(X[n], Y, acc[mt][n], 0, 0, 0);
            }
        }
#pragma unroll
        for (int mt = 0; mt < 8; ++mt) { const int t = 16 * mt + fr; const float bs = a.in[I_ABSP][grp * CHUNK + t];
#pragma unroll
            for (int n = 0; n < 3; ++n) { const size_t off = (size_t)(row0 + t) * AIN + c0 + 48 * wid + 16 * n + 4 * fq;
                const u32x2 uu = *(const GAS u32x2*)(U + off); const f32x4 x = acc[mt][n];
                *(GAS u32x2*)(S + off) = (u32x2){cvt_pk_bf16(bflo(uu.x) * (x[0] + bs), bfhi(uu.x) * (x[1] + bs)), cvt_pk_bf16(bflo(uu.y) * (x[2] + bs), bfhi(uu.y) * (x[3] + bs))}; } }
        __syncthreads();
        { const int uidx = (unit - vcu) / G, NGW = G * NWAVES, gwv = vcu * NWAVES + wid;
          LAS float* cscr = (LAS float*)(lds + wid * 9216);
#pragma unroll 1
          for (int k0 = 0; k0 < 6; k0 += 3) cv64_batch3(a, cscr, (uidx * 6 + k0) * NGW + gwv, NGW, 0, lane); }
    }
    __syncthreads();
}


__device__ __forceinline__ void router_phase(const Args& a, LAS unsigned char* lds, int layer, const float* hin, int vcu) {
    const int tid = threadIdx.x, lane = tid & 63, wid = __builtin_amdgcn_readfirstlane(tid >> 6);
    unsigned char* ws = a.ws;
    LAS float* rw = (LAS float*)lds;
    LAS float* vsc = (LAS float*)(lds + 65536); LAS float* vsh = vsc + D;
    LAS int* ent = (LAS int*)(lds + 65536 + 8192);
    LAS int* lrank = ent + 128; LAS int* lbase = lrank + 128;
    LAS float* gts = (LAS float*)(lbase + 16);
    const int row0 = vcu * 64, b = row0 / SEQ;
    for (int i = tid; i < D * NE; i += NTHR) rw[(i & 15) * D + (i >> 4)] = a.in[I_RW][i];
    load_norm_vecs(a, false, layer, b, 3, a.in[I_N2G] + layer * D, vsc, vsh);
    __syncthreads();
    bf16* HN = (bf16*)(ws + WS_HN);
    f32x4 vv[8][4];
#pragma unroll
    for (int i = 0; i < 8; ++i) { const GAS f32x4* xr = (const GAS f32x4*)(hin + (size_t)(row0 + wid * 8 + i) * D) + lane;
#pragma unroll
        for (int j = 0; j < 4; ++j) vv[i][j] = xr[64 * j]; }
#pragma unroll
    for (int i = 0; i < 8; ++i) {
        const int lr = wid * 8 + i, row = row0 + lr;
        f32x4 (&v)[4] = vv[i];
        rms_mod_row(v, vsc, vsh, lane);
        store_row_bf16(v, HN + (size_t)row * D, lane);
        float lg[16];
#pragma unroll
        for (int e = 0; e < 16; ++e) lg[e] = 0.f;
#pragma unroll
        for (int j = 0; j < 4; ++j)
#pragma unroll
            for (int e = 0; e < 16; ++e) { const f32x4 w = *(const LAS f32x4*)(rw + e * D + 4 * lane + 256 * j); const f32x4 x = v[j];
                lg[e] += (x.x * w.x + x.y * w.y) + (x.z * w.z + x.w * w.w); }
#pragma unroll
        for (int e = 0; e < 16; ++e) lg[e] = wave_sum(lg[e]);
        float aff[16], sel[16];
#pragma unroll
        for (int e = 0; e < 16; ++e) { aff[e] = 1.0f / (1.0f + expf(-lg[e])); sel[e] = aff[e] + a.in[I_RB][e]; }
        int grp = 0; float best = -1e30f;
#pragma unroll
        for (int g = 0; g < 4; ++g) { const float s0 = sel[4 * g], s1 = sel[4 * g + 1], s2 = sel[4 * g + 2], s3 = sel[4 * g + 3];
            const float tot = s0 + s1 + s2 + s3, mn1 = fminf(fminf(s0, s1), fminf(s2, s3));
            float m2 = fmaxf(fmaxf(fmaxf(s0 + s1, s0 + s2), fmaxf(s0 + s3, s1 + s2)), fmaxf(s1 + s3, s2 + s3)); (void)tot; (void)mn1;
            if (m2 > best) { best = m2; grp = g; } }
        float sg[4], ag[4];
#pragma unroll
        for (int j = 0; j < 4; ++j) { sg[j] = 0.f; ag[j] = 0.f; }
#pragma unroll
        for (int g = 0; g < 4; ++g) if (g == grp) {
#pragma unroll
            for (int j = 0; j < 4; ++j) { sg[j] = sel[4 * g + j]; ag[j] = aff[4 * g + j]; } }
        int i0 = 0; float b0 = sg[0];
#pragma unroll
        for (int j = 1; j < 4; ++j) if (sg[j] > b0) { b0 = sg[j]; i0 = j; }
        int i1 = 0; float b1 = -1e30f;
#pragma unroll
        for (int j = 0; j < 4; ++j) if (j != i0 && sg[j] > b1) { b1 = sg[j]; i1 = j; }
        float a0 = 0.f, a1 = 0.f;
#pragma unroll
        for (int j = 0; j < 4; ++j) { if (j == i0) a0 = ag[j]; if (j == i1) a1 = ag[j]; }
        const float inv = 1.0f / (a0 + a1);
        if (lane == 0) { ent[2 * lr] = grp * 4 + i0; ent[2 * lr + 1] = grp * 4 + i1; gts[2 * lr] = a0 * inv; gts[2 * lr + 1] = a1 * inv; }
    }
    __syncthreads();
    if (tid < 16) { int c = 0; for (int i = 0; i < 128; ++i) if (ent[i] == tid) lrank[i] = c++;
        ((unsigned*)(ws + WS_HIST))[(size_t)vcu * 16 + tid] = (unsigned)c; }
    __syncthreads();
}
__device__ __forceinline__ void router_finish(const Args& a, LAS unsigned char* lds, int layer, int vcu, int G) {
    const int tid = threadIdx.x; unsigned char* ws = a.ws;
    LAS int* ent = (LAS int*)(lds + 65536 + 8192); LAS int* lrank = ent + 128; LAS int* lbase = lrank + 128; LAS float* gts = (LAS float*)(lbase + 16);
    const int row0 = vcu * 64;
    LAS unsigned* hl = (LAS unsigned*)lds;
    for (int i = tid; i < G * 4; i += NTHR) *(LAS u32x4*)(hl + 4 * i) = *(const GAS u32x4*)((const unsigned*)(ws + WS_HIST) + 4 * i);
    __syncthreads();
    if (tid < 16) { unsigned base = 0u, tot = 0u;
        for (int b = 0; b < G; ++b) { const unsigned c = hl[b * 16 + tid]; tot += c; if (b < vcu) base += c; }
        lbase[tid] = (int)base;
        if (vcu == 0) __hip_atomic_store((unsigned*)(ws + WS_CTL) + CW_CNT + layer * 1024 + tid * 64, tot, __ATOMIC_RELAXED, __HIP_MEMORY_SCOPE_AGENT); }
    __syncthreads();
    if (tid < 128) { const int e = ent[tid], r = lbase[e] + lrank[tid], tok = row0 + (tid >> 1);
        ((unsigned*)(ws + WS_LIST))[(size_t)e * M + r] = (unsigned)tok;
        ((unsigned*)(ws + WS_TOKINFO))[(size_t)tok * 2 + (tid & 1)] = (unsigned)e | ((unsigned)r << 8);
        ((float*)(ws + WS_TOKINFO + 131072))[(size_t)tok * 2 + (tid & 1)] = gts[tid]; }
    __syncthreads();
}
__device__ __forceinline__ void moe_tables(const Args& a, volatile LAS int* tab, int layer, int ncol) {
    if (threadIdx.x < 64) {
        const int lane = threadIdx.x; const unsigned* cnt = (const unsigned*)(a.ws + WS_CTL) + CW_CNT + layer * 1024;
        const int c = lane < 16 ? (int)__hip_atomic_load(cnt + lane * 64, __ATOMIC_RELAXED, __HIP_MEMORY_SCOPE_AGENT) : 0;
        const int tiles = (c + 255) >> 8; int incl = tiles;
#pragma unroll
        for (int o = 1; o < 16; o <<= 1) { const int u = __shfl_up(incl, o); if (lane >= o) incl += u; }
        const int tp = incl - tiles;
        if (lane < 16) { tab[lane] = tp * ncol; tab[17 + lane] = tiles > 0 ? tiles : 1; tab[33 + lane] = tp * 256; tab[49 + lane] = c; }
        if (lane == 15) { tab[16] = incl * ncol; tab[65] = incl * ncol; }
    }
    __syncthreads();
}
__device__ __forceinline__ void combine_phase(const Args& a, LAS unsigned char* lds, int layer, const float* hin, float* hout, bool do_moe, bool final_, int vcu) {
    const int tid = threadIdx.x, lane = tid & 63, wid = __builtin_amdgcn_readfirstlane(tid >> 6);
    unsigned char* ws = a.ws;
    LAS float* vsc = (LAS float*)lds; LAS float* vsh = vsc + D; LAS float* g2 = vsh + D; LAS int* hr0 = (LAS int*)(g2 + D);
    const int row0 = vcu * 64, b = row0 / SEQ;
    if (final_) { for (int d = tid; d < D; d += NTHR) { vsc[d] = a.in[I_FG][d]; vsh[d] = 0.f; } }
    else load_norm_vecs(a, false, layer + 1, b, 0, a.in[I_N1G] + (layer + 1) * D, vsc, vsh);
    for (int d = tid; d < D; d += NTHR) g2[d] = mod_val(a, false, layer, b, 5 * 1024 + d);
    LAS int* ust = hr0 + 16; LAS int* tl = ust + 16; LAS int* nwgp = tl + 16;
    if (tid < 64) { const unsigned* cnt = (const unsigned*)(ws + WS_CTL) + CW_CNT + layer * 1024;
        const int c = tid < 16 ? (int)__hip_atomic_load(cnt + tid * 64, __ATOMIC_RELAXED, __HIP_MEMORY_SCOPE_AGENT) : 0;
        const int tiles = (c + 255) >> 8; int incl = tiles;
#pragma unroll
        for (int o = 1; o < 16; o <<= 1) { const int u = __shfl_up(incl, o); if (tid >= o) incl += u; }
        const int tp = incl - tiles;
        if (tid < 16) { hr0[tid] = tp * 256; ust[tid] = tp * (D / 256); tl[tid] = tiles > 0 ? tiles : 1; }
        if (tid == 15) nwgp[0] = incl * (D / 256); }
    __syncthreads();
    const bf16* Y = (const bf16*)(ws + WS_YSLOT); const bf16* SLB = (const bf16*)(ws + WS_SLAB);
    const int nwg_d = nwgp[0]; const bool split = (gridDim.x == 256) && nwg_d > 512 && nwg_d - 512 <= 64;
    u32x2 tiv[8]; f32x2 gwv[8];
#pragma unroll
    for (int i = 0; i < 8; ++i) { const int row = row0 + wid * 8 + i; tiv[i] = (u32x2){0u, 0u}; gwv[i] = (f32x2){0.f, 0.f};
        if (do_moe) { tiv[i] = *(const GAS u32x2*)((const unsigned*)(ws + WS_TOKINFO) + (size_t)row * 2); gwv[i] = *(const GAS f32x2*)((const float*)(ws + WS_TOKINFO + 131072) + (size_t)row * 2); } }
#pragma unroll
    for (int i = 0; i < 8; ++i) {
        const int row = row0 + wid * 8 + i;
        f32x4 v[4]; const GAS f32x4* xr = (const GAS f32x4*)(hin + (size_t)row * D) + lane;
#pragma unroll
        for (int j = 0; j < 4; ++j) v[j] = xr[64 * j];
        if (do_moe) {
            const u32x2 ti = tiv[i];
            const f32x2 gw = gwv[i];
            const int e0 = (int)(ti.x & 255u), r0 = (int)(ti.x >> 8), e1 = (int)(ti.y & 255u), r1 = (int)(ti.y >> 8);
            const int s0 = hr0[e0] + r0, s1 = hr0[e1] + r1;
            const float w0 = gw.x, w1 = gw.y;
            const GAS u32x2* y0 = (const GAS u32x2*)(Y + (size_t)s0 * D) + lane; const GAS u32x2* y1 = (const GAS u32x2*)(Y + (size_t)s1 * D) + lane;
            u32x2 yv0[4], yv1[4];
#pragma unroll
            for (int j = 0; j < 4; ++j) { yv0[j] = y0[64 * j]; yv1[j] = y1[64 * j]; }
#pragma unroll
            for (int j = 0; j < 4; ++j) { const f32x4 gg = *(const LAS f32x4*)(g2 + 4 * lane + 256 * j);
                f32x4 a0 = {bflo(yv0[j].x), bfhi(yv0[j].x), bflo(yv0[j].y), bfhi(yv0[j].y)}, a1 = {bflo(yv1[j].x), bfhi(yv1[j].x), bflo(yv1[j].y), bfhi(yv1[j].y)};
                const int wg0 = ust[e0] + j * tl[e0] + (r0 >> 8), wg1 = ust[e1] + j * tl[e1] + (r1 >> 8);
                if (split && wg0 >= 512) { const GAS u32x2* sp = (const GAS u32x2*)(SLB + (size_t)(wg0 - 512) * 4 * 65536 + (size_t)(r0 & 255) * 256) + lane; a0 = (f32x4){0.f, 0.f, 0.f, 0.f};
#pragma unroll
                    for (int q = 0; q < 4; ++q) { const u32x2 w = sp[q * 16384]; a0 = a0 + (f32x4){bflo(w.x), bfhi(w.x), bflo(w.y), bfhi(w.y)}; } }
                if (split && wg1 >= 512) { const GAS u32x2* sp = (const GAS u32x2*)(SLB + (size_t)(wg1 - 512) * 4 * 65536 + (size_t)(r1 & 255) * 256) + lane; a1 = (f32x4){0.f, 0.f, 0.f, 0.f};
#pragma unroll
                    for (int q = 0; q < 4; ++q) { const u32x2 w = sp[q * 16384]; a1 = a1 + (f32x4){bflo(w.x), bfhi(w.x), bflo(w.y), bfhi(w.y)}; } }
                v[j] = v[j] + gg * (a0 * w0 + a1 * w1); }
        }
        if (!final_) { GAS f32x4* o = (GAS f32x4*)(hout + (size_t)row * D) + lane;
#pragma unroll
            for (int j = 0; j < 4; ++j) o[64 * j] = v[j]; }
        rms_mod_row(v, vsc, vsh, lane);
        if (final_) { GAS f32x4* o = (GAS f32x4*)(a.out + (size_t)row * D) + lane;
            if (__hip_atomic_load((const unsigned*)(ws + WS_CTL) + CW_BAR + XB_TMO, __ATOMIC_RELAXED, __HIP_MEMORY_SCOPE_AGENT) != 0u) {
#pragma unroll
                for (int j = 0; j < 4; ++j) v[j] = v[j] + 1000.0f; }
#pragma unroll
            for (int j = 0; j < 4; ++j) o[64 * j] = v[j]; }
        else store_row_bf16(v, (bf16*)(ws + WS_HN) + (size_t)row * D, lane);
    }
    __syncthreads();
}


template <int KD, int ND, bool INF32>
__device__ __forceinline__ void headgemm(const void* in, int rs, int hs, const bf16* W, int wns, int whs, bf16* out, int ors, int ohs, float scale, int gw, int NGW, int lane) {
    const int fr = lane & 15, fq = lane >> 4;
    constexpr int KS = KD / 32, NT = ND / 16;
    const int h = gw & 15;
    bf16x8 Xf[NT][KS];
#pragma unroll
    for (int nt = 0; nt < NT; ++nt)
#pragma unroll
        for (int ks = 0; ks < KS; ++ks) Xf[nt][ks] = *(const GAS bf16x8*)(W + (size_t)(32 * (nt >> 1) + 8 * (fr >> 2) + 4 * (nt & 1) + (fr & 3)) * wns + h * whs + 32 * ks + 8 * fq);
    constexpr int NR = INF32 ? 2 * KS : KS;
    auto loadY = [&](int item, u32x4 (&R)[NR]) __attribute__((always_inline)) {
        const int t0 = (item >> 4) * 16;
#pragma unroll
        for (int ks = 0; ks < KS; ++ks) {
            if (INF32) { const float* p = (const float*)in + (size_t)(t0 + fr) * rs + h * hs + 32 * ks + 8 * fq; R[2 * ks] = *(const GAS u32x4*)p; R[2 * ks + 1] = *(const GAS u32x4*)(p + 4); }
            else R[ks] = *(const GAS u32x4*)((const bf16*)in + (size_t)(t0 + fr) * rs + h * hs + 32 * ks + 8 * fq);
        }
    };
    auto compute = [&](int item, const u32x4 (&R)[NR]) __attribute__((always_inline)) {
        const int t0 = (item >> 4) * 16;
        bf16x8 Y[KS];
#pragma unroll
        for (int ks = 0; ks < KS; ++ks) {
            if (INF32) { const f32x4 x0 = __builtin_bit_cast(f32x4, R[2 * ks]), x1 = __builtin_bit_cast(f32x4, R[2 * ks + 1]);
                const u32x4 w = {cvt_pk_bf16(x0[0], x0[1]), cvt_pk_bf16(x0[2], x0[3]), cvt_pk_bf16(x1[0], x1[1]), cvt_pk_bf16(x1[2], x1[3])}; Y[ks] = __builtin_bit_cast(bf16x8, w); }
            else Y[ks] = __builtin_bit_cast(bf16x8, R[ks]);
        }
#pragma unroll
        for (int nt = 0; nt < NT; nt += 2) {
            f32x4 acc = {0.f, 0.f, 0.f, 0.f}, acc2 = {0.f, 0.f, 0.f, 0.f};
#pragma unroll
            for (int ks = 0; ks < KS; ++ks) { acc = __builtin_amdgcn_mfma_f32_16x16x32_bf16(Xf[nt][ks], Y[ks], acc, 0, 0, 0); acc2 = __builtin_amdgcn_mfma_f32_16x16x32_bf16(Xf[nt + 1][ks], Y[ks], acc2, 0, 0, 0); }
            *(GAS u32x4*)(out + (size_t)(t0 + fr) * ors + h * ohs + 16 * nt + 8 * fq) = (u32x4){cvt_pk_bf16(acc[0] * scale, acc[1] * scale), cvt_pk_bf16(acc[2] * scale, acc[3] * scale), cvt_pk_bf16(acc2[0] * scale, acc2[1] * scale), cvt_pk_bf16(acc2[2] * scale, acc2[3] * scale)};
        }
    };
    const int total = (M / 16) * NH, n = gw < total ? (total - gw + NGW - 1) / NGW : 0;
    u32x4 RA[NR], RB[NR];
    int k = 0;
    if (n > 0) loadY(gw, RA);
    __builtin_amdgcn_sched_barrier(0);
#pragma unroll 1
    while (k + 2 < n) {
        loadY(gw + (k + 1) * NGW, RB);
        __builtin_amdgcn_sched_barrier(0);
        compute(gw + k * NGW, RA);
        __builtin_amdgcn_sched_barrier(0);
        loadY(gw + (k + 2) * NGW, RA);
        __builtin_amdgcn_sched_barrier(0);
        compute(gw + (k + 1) * NGW, RB);
        __builtin_amdgcn_sched_barrier(0);
        k += 2;
    }
    if (n - k == 2) { loadY(gw + (k + 1) * NGW, RB); __builtin_amdgcn_sched_barrier(0); compute(gw + k * NGW, RA); __builtin_amdgcn_sched_barrier(0); compute(gw + (k + 1) * NGW, RB); }
    else if (n - k == 1) compute(gw + k * NGW, RA);
}
__device__ __forceinline__ void post_phase(const Args& a, int gw, int NGW, int lane) {
    unsigned char* ws = a.ws;
    const float* P = (const float*)(ws + WS_PROJ);
    f32x4 cv[8], qa[8], qb[8]; float kk[8], ww[8];
#pragma unroll
    for (int i = 0; i < 8; ++i) { const float* pr = P + (size_t)(gw + i * NGW) * NPROJ;
        cv[i] = *(const GAS f32x4*)(pr + O_CKV + 4 * lane); qa[i] = *(const GAS f32x4*)(pr + O_QI + 8 * lane); qb[i] = *(const GAS f32x4*)(pr + O_QI + 8 * lane + 4);
        kk[i] = pr[O_KI + lane]; ww[i] = pr[O_WI + (lane & (HI - 1))]; }
    const f32x4 g = *(const GAS f32x4*)(a.in[I_BKVG] + 4 * lane); const float kg = a.in[I_BKIG][lane];
#pragma unroll
    for (int i = 0; i < 8; ++i) { const int row = gw + i * NGW; const f32x4 c = cv[i];
        const float r1 = 1.0f / sqrtf(wave_sum((c.x * c.x + c.y * c.y) + (c.z * c.z + c.w * c.w)) * (1.0f / CL) + EPS);
        *(GAS u32x2*)((bf16*)(ws + WS_CKV) + (size_t)row * CL + 4 * lane) = (u32x2){cvt_pk_bf16(c.x * r1 * g.x, c.y * r1 * g.y), cvt_pk_bf16(c.z * r1 * g.z, c.w * r1 * g.w)};
        const f32x4 q0 = qa[i], q1 = qb[i];
        *(GAS u32x4*)((bf16*)(ws + WS_QI) + (size_t)row * 512 + 8 * lane) = (u32x4){cvt_pk_bf16(q0.x, q0.y), cvt_pk_bf16(q0.z, q0.w), cvt_pk_bf16(q1.x, q1.y), cvt_pk_bf16(q1.z, q1.w)};
        const float k = kk[i];
        const float r2 = 1.0f / sqrtf(wave_sum(k * k) * (1.0f / DI) + EPS);
        ((bf16*)(ws + WS_KI))[(size_t)row * DI + lane] = (bf16)f2bf(k * r2 * kg);
        if (lane < HI) ((float*)(ws + WS_WI))[(size_t)row * HI + lane] = ww[i] * 0.04419417382415922f;
    }
    headgemm<HD, CL, true>(P, NPROJ, HD, (const bf16*)(ws + WS_WUK), NH * HD, HD, (bf16*)(ws + WS_QABS), NH * CL, CL, 0.125f, gw, NGW, lane);
}
__device__ __forceinline__ void indexer_phase(const Args& a, int G, int vcu) {
    const int tid = threadIdx.x, lane = tid & 63, wid = __builtin_amdgcn_readfirstlane(tid >> 6), fr = lane & 15, fq = lane >> 4;
    unsigned char* ws = a.ws;
    const bf16* QI = (const bf16*)(ws + WS_QI); const bf16* KI = (const bf16*)(ws + WS_KI); const float* WI = (const float*)(ws + WS_WI); float* SC = (float*)(ws + WS_SC);
    for (int u = vcu; u < NB_ * 528; u += G) {
        const int b = u / 528, r = u % 528;
        int tb = (int)((sqrtf(8.f * r + 1.f) - 1.f) * 0.5f); while ((tb + 1) * (tb + 2) / 2 <= r) ++tb; while (tb * (tb + 1) / 2 > r) --tb;
        const int sb = r - tb * (tb + 1) / 2;
        const int trow = b * SEQ + tb * 128 + 16 * wid + fr, srow0 = b * SEQ + sb * 128;
        bf16x8 Kf[8][2];
#pragma unroll
        for (int n = 0; n < 8; ++n)
#pragma unroll
            for (int ks = 0; ks < 2; ++ks) Kf[n][ks] = *(const GAS bf16x8*)(KI + (size_t)(srow0 + 16 * n + fr) * DI + 32 * ks + 8 * fq);
        f32x4 sc[8];
#pragma unroll
        for (int n = 0; n < 8; ++n) sc[n] = (f32x4){0.f, 0.f, 0.f, 0.f};
        const bf16* qrow = QI + (size_t)trow * 512 + 8 * fq;
        const f32x4 wq0 = *(const GAS f32x4*)(WI + (size_t)trow * HI), wq1 = *(const GAS f32x4*)(WI + (size_t)trow * HI + 4);
        bf16x8 QA0 = *(const GAS bf16x8*)(qrow), QA1 = *(const GAS bf16x8*)(qrow + 32), QB0, QB1;
#define IDX_HEAD(q0_, q1_, w_) do { _Pragma("unroll") for (int n = 0; n < 8; ++n) { f32x4 acc = {0.f, 0.f, 0.f, 0.f}; \
            acc = __builtin_amdgcn_mfma_f32_16x16x32_bf16(Kf[n][0], q0_, acc, 0, 0, 0); acc = __builtin_amdgcn_mfma_f32_16x16x32_bf16(Kf[n][1], q1_, acc, 0, 0, 0); \
            _Pragma("unroll") for (int j = 0; j < 4; ++j) sc[n][j] += (w_) * __builtin_amdgcn_fmed3f(acc[j], 0.f, 3.0e38f); } } while (0)
#pragma unroll 1
        for (int hp = 0; hp < 4; ++hp) {
            const f32x4 wv = hp < 2 ? wq0 : wq1; const float wa = (hp & 1) ? wv.z : wv.x, wb = (hp & 1) ? wv.w : wv.y;
            QB0 = *(const GAS bf16x8*)(qrow + (2 * hp + 1) * 64); QB1 = *(const GAS bf16x8*)(qrow + (2 * hp + 1) * 64 + 32);
            __builtin_amdgcn_sched_barrier(0);
            IDX_HEAD(QA0, QA1, wa);
            __builtin_amdgcn_sched_barrier(0);
            if (hp < 3) { QA0 = *(const GAS bf16x8*)(qrow + (2 * hp + 2) * 64); QA1 = *(const GAS bf16x8*)(qrow + (2 * hp + 2) * 64 + 32); }
            __builtin_amdgcn_sched_barrier(0);
            IDX_HEAD(QB0, QB1, wb);
            __builtin_amdgcn_sched_barrier(0);
        }
#undef IDX_HEAD
#pragma unroll
        for (int n = 0; n < 8; ++n) *(GAS f32x4*)(SC + (size_t)trow * SEQ + sb * 128 + 16 * n + 4 * fq) = sc[n];
    }
}
__device__ __forceinline__ void topk_phase(const Args& a, LAS unsigned char* lds, int gw, int NGW, int wave, int lane) {
    LAS unsigned* hist = (LAS unsigned*)(lds + wave * 17408);
    LAS unsigned* cand = hist + 256;
    const float* SC = (const float*)(a.ws + WS_SC); int* SEL = (int*)(a.ws + WS_SEL);
    const unsigned long long lt = (1ull << lane) - 1ull;
    for (int ri = 0; ri < M / NGW; ++ri) {
        const int rr = gw + ri * NGW, bb = rr / SEQ, tt = rr % SEQ;
        const int t = (tt >= SEQ / 2) ? (3 * SEQ / 2 - 1 - tt) : tt, row = bb * SEQ + t, n = t + 1;
        int* sel = SEL + (size_t)row * KTOP;
        if (n <= KTOP) { for (int j = lane; j < KTOP; j += 64) sel[j] = j < n ? j : 0; continue; }
        const float* sc = SC + (size_t)row * SEQ;
        float v[64]; float mn = 3.0e38f, mx = -3.0e38f;
#pragma unroll
        for (int g = 0; g < 4; ++g) if (g * 1024 < n) {
#pragma unroll
            for (int jj = 0; jj < 16; ++jj) { const int j = g * 16 + jj, s2 = j * 64 + lane; v[j] = sc[s2]; } }
        else {
#pragma unroll
            for (int jj = 0; jj < 16; ++jj) v[g * 16 + jj] = 0.f; }
        __builtin_amdgcn_sched_barrier(0);
#pragma unroll
        for (int g = 0; g < 4; ++g) if (g * 1024 < n) {
#pragma unroll
            for (int jj = 0; jj < 16; ++jj) { const int j = g * 16 + jj, s2 = j * 64 + lane; const float xr = v[j]; const bool ok = s2 < n;
                mn = fminf(mn, ok ? xr : 3.0e38f); mx = fmaxf(mx, ok ? xr : -3.0e38f); v[j] = ok ? xr : 0.f; } }
#pragma unroll
        for (int o = 1; o < 64; o <<= 1) { mn = fminf(mn, __shfl_xor(mn, o)); mx = fmaxf(mx, __shfl_xor(mx, o)); }
        const float range = mx - mn, scale = range > 0.f ? 16777215.0f / range : 0.f;
        *(LAS u32x4*)(hist + 4 * lane) = (u32x4){0u, 0u, 0u, 0u};
        LDS_WAIT();
#pragma unroll
        for (int g = 0; g < 4; ++g) if (g * 1024 < n) {
#pragma unroll
            for (int jj = 0; jj < 16; ++jj) { const int j = g * 16 + jj, s2 = j * 64 + lane; unsigned k = (unsigned)((v[j] - mn) * scale); k = k > 0xFFFFFFu ? 0xFFFFFFu : k;
                v[j] = __builtin_bit_cast(float, k);
                if (s2 < n) __hip_atomic_fetch_add(hist + (k >> 16), 1u, __ATOMIC_RELAXED, __HIP_MEMORY_SCOPE_WORKGROUP); } }
        LDS_WAIT();
        const u32x4 h4 = *(LAS u32x4*)(hist + 4 * lane);
        const unsigned tot = h4.x + h4.y + h4.z + h4.w;
        unsigned suf = tot;
#pragma unroll
        for (int o = 1; o < 64; o <<= 1) { const unsigned u = __shfl_down(suf, o); if (lane + o < 64) suf += u; }
        const unsigned above = suf - tot, kr = (unsigned)KTOP;
        const bool here = (above < kr) && (suf >= kr);
        const unsigned long long bm = __ballot(here); const int L = bm ? (__ffsll((long long)bm) - 1) : 0;
        const unsigned c3 = above + h4.w, c2 = c3 + h4.z, c1 = c2 + h4.y;
        int binl; unsigned ab;
        if (c3 >= kr) { binl = 3; ab = above; } else if (c2 >= kr) { binl = 2; ab = c3; } else if (c1 >= kr) { binl = 1; ab = c2; } else { binl = 0; ab = c1; }
        const unsigned b0 = (unsigned)__shfl(4 * lane + binl, L); const int abv = (int)__shfl(ab, L); const int krem = KTOP - abv;
        int pos = 0, ccnt = 0;
#pragma unroll
        for (int g = 0; g < 4; ++g) if (g * 1024 < n) {
#pragma unroll
            for (int jj = 0; jj < 16; ++jj) { const int j = g * 16 + jj, s2 = j * 64 + lane; const unsigned k = __builtin_bit_cast(unsigned, v[j]); const unsigned d = k >> 16; const bool valid = s2 < n;
                const bool gt = valid && d > b0, eq = valid && d == b0;
                const unsigned long long gm = __ballot(gt), em = __ballot(eq);
                if (gt) sel[pos + __popcll(gm & lt)] = s2;
                if (eq) cand[ccnt + __popcll(em & lt)] = ((k & 0xFFFFu) << 12) | (unsigned)(4095 - s2);
                pos += __popcll(gm); ccnt += __popcll(em); } }
        LDS_WAIT();
        for (int i0 = 0; i0 < ccnt; i0 += 64) { const int i = i0 + lane; const unsigned mine = i < ccnt ? cand[i] : 0xFFFFFFFFu; int rank = 0;
            for (int q = 0; q < ccnt; ++q) rank += (cand[q] > mine) ? 1 : 0;
            if (i < ccnt && rank < krem) sel[abv + rank] = 4095 - (int)(mine & 4095u); }
        LDS_WAIT();
    }
}
__device__ const unsigned char T5_BUCKET[128] = {0,1,2,3,4,5,6,7,8,9,10,11,12,13,14,15,16,16,16,17,17,18,18,18,19,19,19,20,20,20,20,21,21,21,21,22,22,22,22,22,23,23,23,23,23,23,24,24,24,24,24,24,25,25,25,25,25,25,25,26,26,26,26,26,26,26,26,27,27,27,27,27,27,27,27,27,27,28,28,28,28,28,28,28,28,28,28,29,29,29,29,29,29,29,29,29,29,29,29,30,30,30,30,30,30,30,30,30,30,30,30,30,30,31,31,31,31,31,31,31,31,31,31,31,31,31,31,31};
constexpr int ATT_STG = 147456;
constexpr int ATT_PAIR = 1040, ATT_BUF = 8 * ATT_PAIR, ATT_TABO = NWAVES * 2 * ATT_BUF;
__device__ __forceinline__ void attn_phase(const Args& a, LAS unsigned char* lds, int vcu, int G, int wave, int lane) {
    const int tid = threadIdx.x, fr = lane & 15, fq = lane >> 4, q4 = fr >> 2, p4 = fr & 3;
    unsigned char* ws = a.ws;
    LAS unsigned char* kvb = lds + wave * (2 * ATT_BUF);
    LAS float* rb = (LAS float*)(lds + ATT_TABO); LAS int* bkt = (LAS int*)(lds + ATT_TABO + 2048);
    for (int i = tid; i < 32 * NH; i += NTHR) rb[i] = a.in[I_RELB][i];
    if (tid < 128) bkt[tid] = T5_BUCKET[tid];
    __syncthreads();
    const bf16* QABS = (const bf16*)(ws + WS_QABS); const unsigned char* CKVB = (const unsigned char*)(ws + WS_CKV); const int* SEL = (const int*)(ws + WS_SEL); bf16* OLAT = (bf16*)(ws + WS_OLAT);
    const int bpb = G / NB_, b = vcu / bpb, lb = vcu % bpb, nbw = bpb * NWAVES;
    const int trrow = 4 * fq + q4, trbase = (trrow >> 1) * ATT_PAIR + (trrow & 1) * 512 + 8 * (p4 & 1), trrot = (trrow & 1) ? 24 : 0;
    const int qbase = (fr >> 1) * ATT_PAIR + (fr & 1) * 512, qrot = (fr & 1) ? 24 : 0;
    LAS unsigned* kof = (LAS unsigned*)(lds + ATT_STG + wave * 2048); LAS int* bks = (LAS int*)(kof + 256);
    const int wpos = (lane >> 4) * 16 + (lane & 1) * 8 + ((lane & 15) >> 1);
    const unsigned lcx = (unsigned)((((lane & 31) + ((lane >> 5) << 3)) & 31) << 4);
    if (b < NB_)
    for (int t = lb * NWAVES + wave; t < SEQ; t += nbw) {
        const int row = b * SEQ + t, cnt = (t + 1 < KTOP) ? t + 1 : KTOP, nst = (cnt + 15) >> 4;
        bf16x8 Q[8];
#pragma unroll
        for (int ks = 0; ks < 8; ++ks) Q[ks] = *(const GAS bf16x8*)(QABS + ((size_t)row * NH + fr) * CL + 32 * ks + 8 * fq);
        const int* sel = SEL + (size_t)row * KTOP;
        const int sr0 = sel[lane], sr1 = sel[64 + lane], sr2 = sel[128 + lane], sr3 = sel[192 + lane];
        int br0, br1, br2, br3;
        { const int d0 = t - sr0, d1 = t - sr1, d2 = t - sr2, d3 = t - sr3;
          br0 = (d0 < 128 ? bkt[d0 < 0 ? 0 : d0] : 31) * NH; br1 = (d1 < 128 ? bkt[d1 < 0 ? 0 : d1] : 31) * NH; br2 = (d2 < 128 ? bkt[d2 < 0 ? 0 : d2] : 31) * NH; br3 = (d3 < 128 ? bkt[d3 < 0 ? 0 : d3] : 31) * NH; }
        const unsigned ko0 = (unsigned)(b * SEQ + sr0) * 512u, ko1 = (unsigned)(b * SEQ + sr1) * 512u, ko2 = (unsigned)(b * SEQ + sr2) * 512u, ko3 = (unsigned)(b * SEQ + sr3) * 512u;
        kof[wpos] = ko0; kof[64 + wpos] = ko1; kof[128 + wpos] = ko2; kof[192 + wpos] = ko3;
        bks[lane] = br0; bks[64 + lane] = br1; bks[128 + lane] = br2; bks[192 + lane] = br3;
        f32x4 o[16];
#pragma unroll
        for (int nt = 0; nt < 16; ++nt) o[nt] = (f32x4){0.f, 0.f, 0.f, 0.f};
        float mrun = -1e30f, lsum = 0.f;
        VM_WAIT();
#define ATT_DMA(st_) do { const int st__ = (st_); LAS unsigned char* dst_ = kvb + (st__ & 1) * ATT_BUF; \
        const u32x4 ka_ = *(const LAS u32x4*)(kof + st__ * 16 + (lane >> 5) * 8), kb_ = *(const LAS u32x4*)(kof + st__ * 16 + (lane >> 5) * 8 + 4); \
        const unsigned kk_[8] = {ka_.x, ka_.y, ka_.z, ka_.w, kb_.x, kb_.y, kb_.z, kb_.w}; \
        LDS_WAIT(); __builtin_amdgcn_sched_barrier(0); \
        _Pragma("unroll") for (int i_ = 0; i_ < 8; ++i_) \
            __builtin_amdgcn_global_load_lds((const unsigned*)(CKVB + (kk_[i_] + lcx)), (LAS unsigned*)(dst_ + i_ * ATT_PAIR), 16, 0, 0); } while (0)
        LDS_WAIT(); __builtin_amdgcn_sched_barrier(0);
        ATT_DMA(0);
        for (int st = 0; st < nst; ++st) {
            LAS unsigned char* kv = kvb + (st & 1) * ATT_BUF;
            const u32x4 b4_ = *(const LAS u32x4*)(bks + st * 16 + 4 * fq);
            const int bk4[4] = {(int)b4_.x, (int)b4_.y, (int)b4_.z, (int)b4_.w};
            LDS_WAIT(); __builtin_amdgcn_sched_barrier(0);
            if (st + 1 < nst) { ATT_DMA(st + 1); asm volatile("s_waitcnt vmcnt(8)" ::: "memory"); }
            else asm volatile("s_waitcnt vmcnt(0)" ::: "memory");
            __builtin_amdgcn_sched_barrier(0);
            f32x4 lg = {0.f, 0.f, 0.f, 0.f}, lg2 = {0.f, 0.f, 0.f, 0.f};
#pragma unroll
            for (int ks = 0; ks < 8; ks += 2) { const bf16x8 X = *(const LAS bf16x8*)(kv + qbase + (((4 * ks + fq + qrot) & 31) << 4)), X2 = *(const LAS bf16x8*)(kv + qbase + (((4 * (ks + 1) + fq + qrot) & 31) << 4));
                lg = __builtin_amdgcn_mfma_f32_16x16x32_bf16(X, Q[ks], lg, 0, 0, 0); lg2 = __builtin_amdgcn_mfma_f32_16x16x32_bf16(X2, Q[ks + 1], lg2, 0, 0, 0); }
            lg = lg + lg2;
            float x[4]; float mx = -1e30f;
#pragma unroll
            for (int j = 0; j < 4; ++j) { const int kidx = st * 16 + 4 * fq + j; float v = lg[j] + rb[bk4[j] + fr]; if (kidx >= cnt) v = -1e30f; x[j] = v; mx = fmaxf(mx, v); }
            { const auto s16 = __builtin_amdgcn_permlane16_swap(__builtin_bit_cast(unsigned, mx), __builtin_bit_cast(unsigned, mx), false, false);
              mx = fmaxf(__builtin_bit_cast(float, (unsigned)s16[0]), __builtin_bit_cast(float, (unsigned)s16[1]));
              const auto s32 = __builtin_amdgcn_permlane32_swap(__builtin_bit_cast(unsigned, mx), __builtin_bit_cast(unsigned, mx), false, false);
              mx = fmaxf(__builtin_bit_cast(float, (unsigned)s32[0]), __builtin_bit_cast(float, (unsigned)s32[1])); }
            const float mnew = fmaxf(mrun, mx);
            if (__any(mnew > mrun)) { const float alpha = fast_exp(mrun - mnew); lsum *= alpha;
#pragma unroll
                for (int nt = 0; nt < 16; ++nt) o[nt] = o[nt] * alpha; }
            mrun = mnew;
            float pv[4]; float ps = 0.f;
#pragma unroll
            for (int j = 0; j < 4; ++j) { pv[j] = fast_exp(x[j] - mnew); ps += pv[j]; }
            lsum += ps;
            const u32x2 pw = {cvt_pk_bf16(pv[0], pv[1]), cvt_pk_bf16(pv[2], pv[3])};
            const bf16x4 Pf = __builtin_bit_cast(bf16x4, pw);
            {
                const unsigned kva = (unsigned)(size_t)kv + (unsigned)trbase;
                bf16x4 XA[4], XB[4];
#define ATT_TR(dst_, g_) _Pragma("unroll") for (int nt = 0; nt < 4; ++nt) asm volatile("ds_read_b64_tr_b16 %0, %1" : "=v"(dst_[nt]) : "v"(kva + (unsigned)(((2 * (nt + 4 * (g_)) + (p4 >> 1) + trrot) & 31) << 4)))
#define ATT_TW(x_) asm volatile("s_waitcnt lgkmcnt(0)" : "+v"(x_[0]), "+v"(x_[1]), "+v"(x_[2]), "+v"(x_[3]))
#define ATT_MM(x_, g_) _Pragma("unroll") for (int nt = 0; nt < 4; ++nt) o[nt + 4 * (g_)] = __builtin_amdgcn_mfma_f32_16x16x16bf16_1k(x_[nt], Pf, o[nt + 4 * (g_)], 0, 0, 0)
                ATT_TR(XA, 0); ATT_TW(XA); ATT_TR(XB, 1); ATT_MM(XA, 0); ATT_TW(XB); ATT_TR(XA, 2); ATT_MM(XB, 1); ATT_TW(XA); ATT_TR(XB, 3); ATT_MM(XA, 2); ATT_TW(XB); ATT_MM(XB, 3);
#undef ATT_TR
#undef ATT_TW
#undef ATT_MM
            }
        }
#undef ATT_DMA
        lsum += __shfl_xor(lsum, 16); lsum += __shfl_xor(lsum, 32);
        const float inv = 1.0f / lsum;
#pragma unroll
        for (int nt = 0; nt < 16; ++nt) *(GAS u32x2*)(OLAT + ((size_t)row * NH + fr) * CL + 16 * nt + 4 * fq) = (u32x2){cvt_pk_bf16(o[nt][0] * inv, o[nt][1] * inv), cvt_pk_bf16(o[nt][2] * inv, o[nt][3] * inv)};
        LDS_WAIT();
        { const int slot = (t - (lb * NWAVES + wave)) / nbw;
          const int gwv = (b * bpb + lb) * NWAVES + wave;
          const int NGWV = NB_ * bpb * NWAVES, total = 3 * 16 * 1792;
          cv64_batch3(a, (LAS float*)kvb, (slot * 3) * NGWV + gwv, NGWV, 1, lane); }
    }
    LDS_WAIT();
    __syncthreads();
}


constexpr int NPH = 20;
__global__ void __launch_bounds__(NTHR, 2) fwd(Args args) {
    extern __shared__ __attribute__((aligned(16))) unsigned char smem[];
    LAS unsigned char* lds = (LAS unsigned char*)smem;
    volatile LAS unsigned* MISC = (volatile LAS unsigned*)(lds + MISC_OFF);
    volatile LAS int* tab = (volatile LAS int*)(lds + MISC_OFF + 256);
    const int tid = threadIdx.x, lane = tid & 63, wave = __builtin_amdgcn_readfirstlane(tid >> 6);
    const int G = gridDim.x; const int bx = blockIdx.x; const int vcu = (G % 8 == 0) ? (bx % 8) * (G / 8) + bx / 8 : bx;
    const int gw = vcu * NWAVES + wave, NGW = G * NWAVES;
    unsigned char* ws = args.ws;
    if (tid < 64) MISC[tid] = 0u;
    __syncthreads();
    const int lo = args.ph_lo, hi = args.ph_hi;
    XcdBarrier bar; bar.bar = (unsigned*)(ws + WS_CTL) + CW_BAR; bar.x = 0; bar.st = nullptr;
    if (hi - lo > 1) bar = xcd_barrier_post((unsigned*)(ws + WS_CTL) + CW_BAR, MISC + 8);
#ifndef MK_MASK
#define MK_MASK 0xFFFFFu
#endif
#define IN(k) (((MK_MASK >> (k)) & 1u) && lo <= (k) && (k) < hi)
#ifndef MK_DBL
#define MK_DBL 0u
#endif
#define REP(k) for (int rep_ = 0; rep_ < (int)((MK_DBL >> (k)) & 1u) + 1; ++rep_)
#define SEAM(k) do { if (IN(k) && IN((k) + 1)) xcd_barrier(bar); } while (0)
    const float* X = args.in[I_X];
    float* HA = (float*)(ws + WS_HA); float* HB = (float*)(ws + WS_HB); bf16* HN = (bf16*)(ws + WS_HN);
    const float* MODF = (const float*)(ws + WS_MODF);

    if (IN(0)) REP(0) p0_prologue(args, lds, gw, NGW, wave, lane);
    SEAM(0);
    if (IN(1)) REP(1) {
        if (tid < 192) { const int idx = vcu * 192 + tid; if (idx < 49152) { float s = args.in[I_ADAB][(idx / 24576) * 6144 + idx % 6144]; const float* mp = (const float*)(ws + WS_MODP) + idx;
#pragma unroll
            for (int ks = 0; ks < 8; ++ks) s += mp[(size_t)ks * 49152];
            ((float*)(ws + WS_MODF))[idx] = s; } }
        LAS float* vsc = (LAS float*)lds; LAS float* vsh = vsc + D;
        const int row0 = vcu * 64, b = row0 / SEQ;
        load_norm_vecs(args, true, 0, b, 0, args.in[I_N1G], vsc, vsh);
        __syncthreads();
        f32x4 vv[8][4];
#pragma unroll
        for (int i = 0; i < 8; ++i) { const GAS f32x4* xr = (const GAS f32x4*)(X + (size_t)(row0 + wave * 8 + i) * D) + lane;
#pragma unroll
            for (int j = 0; j < 4; ++j) vv[i][j] = xr[64 * j]; }
#pragma unroll
        for (int i = 0; i < 8; ++i) { rms_mod_row(vv[i], vsc, vsh, lane); store_row_bf16(vv[i], HN + (size_t)(row0 + wave * 8 + i) * D, lane); }
        __syncthreads();
    }
    SEAM(1);
    if (IN(2)) REP(2) {
        pg8::DenseSched S; S.init(HN, (const bf16*)(ws + WS_WINA), M, NZ, D, G, bx);
        pg8::EpiGeluUV E{(bf16*)(ws + WS_U), (bf16*)(ws + WS_V), (f32x2*)(ws + WS_VSTAT)};
        pg8::gemm_phase(lds, S, E);
    }
    SEAM(2);
    if (IN(3)) REP(3) spatial_phase(args, lds, G, vcu);
    SEAM(3);
    if (IN(4)) REP(4) {
        pg8::DenseSched S; S.init((const bf16*)(ws + WS_S), (const bf16*)(ws + WS_WOUTA), M, D, AIN, G, bx);
        pg8::EpiResid E{X, HA, MODF + 0 * 24576 + 2 * 1024};
        pg8::gemm_phase(lds, S, E);
    }
    SEAM(4);
#if MK_STAGE >= 2
    if (IN(5)) REP(5) router_phase(args, lds, 0, HA, vcu);
    SEAM(5);
    if (IN(6)) REP(6) {
        router_finish(args, lds, 0, vcu, G); xcd_barrier(bar);
        moe_tables(args, tab, 0, NGU / 256);
        pg8::MoeSched S{HN, (const bf16*)(ws + WS_WGU), (const unsigned*)(ws + WS_LIST), tab, D, NGU / 256, G, bx, true, (size_t)NGU * D * 2, (LAS unsigned*)(lds + 132 * 1024), false};
        pg8::EpiSwiGLU E{(bf16*)(ws + WS_HMOE)};
        pg8::gemm_phase(lds, S, E);
    }
    SEAM(6);
    if (IN(7)) REP(7) {
        moe_tables(args, tab, 0, D / 256);
        pg8::MoeSched S{(const bf16*)(ws + WS_HMOE), (const bf16*)(ws + WS_WD), (const unsigned*)(ws + WS_LIST), tab, DE, D / 256, G, bx, false, (size_t)D * DE * 2, (LAS unsigned*)(lds + 132 * 1024), true};
        pg8::EpiYbf E{(bf16*)(ws + WS_YSLOT), (bf16*)(ws + WS_SLAB)};
        pg8::gemm_phase(lds, S, E);
    }
    SEAM(7);
    if (IN(8)) REP(8) combine_phase(args, lds, 0, HA, HB, true, false, vcu);
    SEAM(8);
#endif
#if MK_STAGE >= 3
    if (IN(9)) REP(9) {
        pg8::DenseSched S; S.init(HN, (const bf16*)(ws + WS_WINB), M, NPROJ, D, G, bx);
        pg8::EpiF32 E{(float*)(ws + WS_PROJ), NPROJ, nullptr};
        pg8::gemm_phase(lds, S, E);
    }
    SEAM(9);
    if (IN(10)) REP(10) post_phase(args, gw, NGW, lane);
    SEAM(10);
    if (IN(11)) REP(11) indexer_phase(args, G, vcu);
    SEAM(11);
    if (IN(12)) REP(12) topk_phase(args, lds, gw, NGW, wave, lane);
    SEAM(12);
    if (IN(13)) REP(13) attn_phase(args, lds, vcu, G, wave, lane);
    SEAM(13);
    if (IN(14)) REP(14) headgemm<CL, HD, false>((const void*)(ws + WS_OLAT), NH * CL, CL, (const bf16*)(ws + WS_WUVT), CL, HD * CL, (bf16*)(ws + WS_O), D, HD, 1.0f, gw, NGW, lane);
    SEAM(14);
    if (IN(15)) REP(15) {
        pg8::DenseSched S; S.init((const bf16*)(ws + WS_O), (const bf16*)(ws + WS_WOUTB), M, D, D, G, bx);
        pg8::EpiResid E{HB, HA, MODF + 1 * 24576 + 2 * 1024};
        pg8::gemm_phase(lds, S, E);
    }
    SEAM(15);
#endif
#if MK_STAGE >= 9
    if (IN(16)) REP(16) router_phase(args, lds, 1, HA, vcu);
    SEAM(16);
    if (IN(17)) REP(17) {
        router_finish(args, lds, 1, vcu, G); xcd_barrier(bar);
        moe_tables(args, tab, 1, NGU / 256);
        pg8::MoeSched S{HN, (const bf16*)(ws + WS_WGU) + (size_t)NE * NGU * D, (const unsigned*)(ws + WS_LIST), tab, D, NGU / 256, G, bx, true, (size_t)NGU * D * 2, (LAS unsigned*)(lds + 132 * 1024), false};
        pg8::EpiSwiGLU E{(bf16*)(ws + WS_HMOE)};
        pg8::gemm_phase(lds, S, E);
    }
    SEAM(17);
    if (IN(18)) REP(18) {
        moe_tables(args, tab, 1, D / 256);
        pg8::MoeSched S{(const bf16*)(ws + WS_HMOE), (const bf16*)(ws + WS_WD) + (size_t)NE * D * DE, (const unsigned*)(ws + WS_LIST), tab, DE, D / 256, G, bx, false, (size_t)D * DE * 2, (LAS unsigned*)(lds + 132 * 1024), true};
        pg8::EpiYbf E{(bf16*)(ws + WS_YSLOT), (bf16*)(ws + WS_SLAB)};
        pg8::gemm_phase(lds, S, E);
    }
    SEAM(18);
    if (IN(19)) REP(19) combine_phase(args, lds, 1, HA, nullptr, true, true, vcu);
#elif MK_STAGE >= 3
    if (IN(19)) REP(19) combine_phase(args, lds, 1, HA, nullptr, false, true, vcu);
#elif MK_STAGE >= 2
    if (IN(19)) REP(19) combine_phase(args, lds, 1, HB, nullptr, false, true, vcu);
#else
    if (IN(19)) REP(19) combine_phase(args, lds, 1, HA, nullptr, false, true, vcu);
#endif
#undef IN
#undef SEAM
}

extern "C" void kernel_launch(void* const* d_in, const int* in_sizes, int n_in, void* d_out, int out_size, void* d_ws, size_t ws_size, hipStream_t stream) {
    static int grid = 0;
    if (grid == 0) {
        if (n_in != 25 || in_sizes[0] != M * D || out_size != M * D || ws_size < WS_END) { fprintf(stderr, "kernel_launch: unexpected shapes / workspace (%d inputs, ws %zu < %zu)\n", n_in, ws_size, (size_t)WS_END); grid = -1; return; }
        int dev = 0, cus = 0, per_cu = 0;
        if (hipGetDevice(&dev) != hipSuccess || hipDeviceGetAttribute(&cus, hipDeviceAttributeMultiprocessorCount, dev) != hipSuccess) { grid = -1; return; }
        if (hipFuncSetAttribute((const void*)fwd, hipFuncAttributeMaxDynamicSharedMemorySize, LDS_BYTES) != hipSuccess) { fprintf(stderr, "kernel_launch: hipFuncSetAttribute failed\n"); grid = -1; return; }
        if (hipOccupancyMaxActiveBlocksPerMultiprocessor(&per_cu, (const void*)fwd, NTHR, LDS_BYTES) != hipSuccess || per_cu < 1) fprintf(stderr, "kernel_launch: occupancy query says %d\n", per_cu);
        (void)hipGetLastError();
        grid = cus;
    }
    if (grid < 0) return;
    if (hipMemsetAsync((char*)d_ws + WS_CTL, 0, CTL_ZERO_BYTES, stream) != hipSuccess) return;
    Args a{};
    for (int i = 0; i < 25; ++i) a.in[i] = (const float*)d_in[i];
    a.out = (float*)d_out; a.ws = (unsigned char*)d_ws;
    a.ph_lo = 0; a.ph_hi = NPH;
    hipLaunchKernelGGL(fwd, dim3(grid), dim3(NTHR), LDS_BYTES, stream, a);
}
```

```cpp
#include <hip/hip_runtime.h>
#include <cstdio>
#include <cstdint>

#ifndef MK_STAGE
#define MK_STAGE 9
#endif

#define GAS __attribute__((address_space(1)))
#define LAS __attribute__((address_space(3)))
typedef unsigned short bf16;
typedef short bf16x8 __attribute__((ext_vector_type(8)));
typedef short bf16x4 __attribute__((ext_vector_type(4)));
typedef float f32x4 __attribute__((ext_vector_type(4)));
typedef float f32x2 __attribute__((ext_vector_type(2)));
typedef unsigned u32x4 __attribute__((ext_vector_type(4)));
typedef unsigned u32x2 __attribute__((ext_vector_type(2)));
typedef int i32x4 __attribute__((ext_vector_type(4)));
typedef short v4i16_t __attribute__((ext_vector_type(4)));

constexpr int NB_ = 4, SEQ = 4096, D = 1024, M = NB_ * SEQ;
constexpr int AIN = 3072, NZ = 6144, NGRP = 8, GW = 384, CHUNK = 128;
constexpr int NH = 16, HD = 64, CL = 256, HI = 8, DI = 64, KTOP = 256;
constexpr int BPROJ = 1864, NPROJ = 2048;
constexpr int O_CKV = 1024, O_QI = 1280, O_KI = 1792, O_WI = 1856;
constexpr int NE = 16, DE = 3584, NGU = 7168;
constexpr int PMAX = 2 * M + NE * 256;
constexpr float EPS = 1e-6f;

constexpr size_t MiB = 1u << 20;
constexpr size_t WS_CTL = 0, CTL_ZERO_BYTES = 1 * MiB;
constexpr size_t WS_WINA = 2 * MiB, WS_WOUTA = 14 * MiB, WS_WINB = 20 * MiB, WS_WOUTB = 24 * MiB;
constexpr size_t WS_WUK = 26 * MiB, WS_WUVT = 26 * MiB + 512 * 1024, WS_WSP = 27 * MiB;
constexpr size_t WS_MODP = 28 * MiB, WS_MODF = 30 * MiB, WS_TOKINFO = 31 * MiB, WS_LIST = 31 * MiB + 512 * 1024;
constexpr size_t WS_HIST = 32 * MiB + 512 * 1024;
constexpr size_t WS_VSTAT = 33 * MiB, WS_HN = 40 * MiB, WS_HA = 72 * MiB, WS_HB = 136 * MiB;
constexpr size_t WS_WGU = 200 * MiB, WS_WD = 648 * MiB, WS_BIG = 872 * MiB;
constexpr size_t WS_U = WS_BIG, WS_V = WS_BIG + 96 * MiB, WS_S = WS_BIG + 192 * MiB;
constexpr size_t WS_HMOE = WS_BIG, WS_YSLOT = WS_BIG + 256 * MiB, WS_SLAB = WS_BIG + 400 * MiB;
constexpr size_t WS_PROJ = WS_BIG, WS_OLAT = WS_BIG, WS_QABS = WS_BIG + 128 * MiB, WS_SC = WS_BIG + 256 * MiB;
constexpr size_t WS_SEL = WS_BIG + 512 * MiB, WS_CKV = WS_BIG + 528 * MiB, WS_QI = WS_BIG + 536 * MiB, WS_KI = WS_BIG + 552 * MiB;
constexpr size_t WS_WI = WS_BIG + 554 * MiB, WS_O = WS_BIG + 556 * MiB, WS_END = WS_BIG + 588 * MiB;
static_assert((size_t)PMAX * DE * 2 <= 256 * MiB && (size_t)PMAX * D * 4 <= 144 * MiB, "moe buffers");
constexpr int CW_TMO = 0, CW_BAR = 4096, CW_CNT = 8192;

constexpr int RING_BYTES = 131072, MISC_OFF = 140 * 1024, LDS_BYTES = 163840;
constexpr int TAB_OFF = RING_BYTES;
constexpr int NWAVES = 8, NTHR = 512;

#define LDS_WAIT() asm volatile("s_waitcnt lgkmcnt(0)" ::: "memory")
#define VM_WAIT() asm volatile("s_waitcnt vmcnt(0)" ::: "memory")

typedef __bf16 bf16x2_t __attribute__((ext_vector_type(2)));
__device__ __forceinline__ unsigned cvt_pk_bf16(float lo, float hi) { const f32x2 v = {lo, hi}; const bf16x2_t b = __builtin_convertvector(v, bf16x2_t); return __builtin_bit_cast(unsigned, b); }
__device__ __forceinline__ float bf2f(unsigned short b) { return __builtin_bit_cast(float, ((unsigned)b) << 16); }
__device__ __forceinline__ float bflo(unsigned w) { return __builtin_bit_cast(float, w << 16); }
__device__ __forceinline__ float bfhi(unsigned w) { return __builtin_bit_cast(float, w & 0xffff0000u); }
__device__ __forceinline__ float wave_sum(float v) {
#pragma unroll
    for (int o = 1; o < 64; o <<= 1) v += __shfl_xor(v, o);
    return v;
}
__device__ __forceinline__ float fast_exp(float x) { return __builtin_amdgcn_exp2f(x * 1.44269504089f); }
__device__ __forceinline__ float sigmoidf_(float x) { return __builtin_amdgcn_rcpf(1.0f + fast_exp(-x)); }

#define XB_TMO      128
#define XB_XCNT(j)  (256  + 64 * (j))
#define XB_XSUB(j)  (1280 + 64 * (j))
#define XB_XGEN(j)  (2304 + 64 * (j))
#define XB_TOP      3328
#define XB_TOPGEN   3392
#define XCD_BAR_WORDS 3456
#define XB_SPIN_CAP (1u << 18)
__device__ __forceinline__ unsigned xb_ld(unsigned* p)              { return __hip_atomic_load(p, __ATOMIC_RELAXED, __HIP_MEMORY_SCOPE_AGENT); }
__device__ __forceinline__ unsigned xb_add(unsigned* p, unsigned v) { return __hip_atomic_fetch_add(p, v, __ATOMIC_RELAXED, __HIP_MEMORY_SCOPE_AGENT); }
__device__ __forceinline__ unsigned xb_xcc_id() { return (unsigned)__builtin_amdgcn_s_getreg((3 << 11) | 20) & 0xFu; }
#define XB_SPIN(cond, bar) do { unsigned _sp = 0; while (cond) { __builtin_amdgcn_s_sleep(1); \
    if ((++_sp & 255u) == 0u) { if (xb_ld(&(bar)[XB_TMO])) break; if (_sp > XB_SPIN_CAP) { atomicAdd(&(bar)[XB_TMO], 1u); break; } } } } while (0)
struct XcdBarrier { unsigned* bar; unsigned x; volatile LAS unsigned* st; };
__device__ __forceinline__ XcdBarrier xcd_barrier_post(unsigned* bar, volatile LAS unsigned* st) {
    XcdBarrier b; b.bar = bar; b.x = xb_xcc_id(); b.st = st;
    if (threadIdx.x == 0) (void)xb_add(&bar[XB_XCNT(b.x)], 1u);
    return b;
}
__device__ __forceinline__ void xcd_barrier_complete(unsigned* bar, unsigned x, unsigned& nloc, unsigned& nx) {
    const unsigned G = gridDim.x * gridDim.y * gridDim.z;
    unsigned sum, cnt, mine, sp = 0u;
    for (;;) {
        sum = 0u; cnt = 0u; mine = 0u;
#pragma unroll
        for (unsigned j = 0; j < 16; ++j) { const unsigned c = xb_ld(&bar[XB_XCNT(j)]); sum += c; cnt += (c > 0u) ? 1u : 0u; mine = (j == x) ? c : mine; }
        if (sum == G) break;
        __builtin_amdgcn_s_sleep(1);
        if ((++sp & 255u) == 0u) { if (xb_ld(&bar[XB_TMO])) break; if (sp > XB_SPIN_CAP) { atomicAdd(&bar[XB_TMO], 1u); break; } }
    }
    nloc = mine > 0u ? mine : 1u; nx = cnt > 0u ? cnt : 1u;
}
__device__ __forceinline__ void xcd_barrier(const XcdBarrier& b) {
    asm volatile("s_waitcnt vmcnt(0)" ::: "memory");
    __syncthreads();
    if (threadIdx.x == 0) {
        unsigned* bar = b.bar;
        __builtin_amdgcn_s_waitcnt(0);
        unsigned nloc = b.st[0], nx = b.st[1];
        if (nloc == 0u) { xcd_barrier_complete(bar, b.x, nloc, nx); b.st[0] = nloc; b.st[1] = nx; }
        const unsigned old = xb_add(&bar[XB_XSUB(b.x)], 1u);
        const unsigned gen = old / nloc;
        if (old + 1u == (gen + 1u) * nloc) {
            __builtin_amdgcn_fence(__ATOMIC_RELEASE, "agent");
            asm volatile("s_waitcnt vmcnt(0)" ::: "memory");
            const unsigned og = xb_add(&bar[XB_TOP], 1u);
            const unsigned tg = og / nx;
            if (og + 1u == (tg + 1u) * nx) xb_add(&bar[XB_TOPGEN], 1u);
            else XB_SPIN(xb_ld(&bar[XB_TOPGEN]) == tg, bar);
            __builtin_amdgcn_fence(__ATOMIC_ACQUIRE, "agent");
            xb_add(&bar[XB_XGEN(b.x)], 1u);
            asm volatile("s_waitcnt vmcnt(0)" ::: "memory");
        } else {
            XB_SPIN(xb_ld(&bar[XB_XGEN(b.x)]) == gen, bar);
            __builtin_amdgcn_fence(__ATOMIC_ACQUIRE, "agent");
            asm volatile("s_waitcnt vmcnt(0)" ::: "memory");
        }
    }
    __syncthreads();
}

namespace pg8 {
constexpr int BM = 256, BK = 64, HALF = 128, HTB = HALF * BK * 2, STAGE_BYTES = 8 * HTB, NXCD = 8, WGM = 8;
__device__ __forceinline__ int lds_byte(int r, int c) { const int st = (r >> 4) * 2 + (c >> 5), rr = r & 15, cc = c & 31, ob = rr * 64 + cc * 2; return st * 1024 + (ob ^ (((ob >> 9) & 1) << 5)); }
__device__ __forceinline__ void stage_rc(int b, int& R, int& C) { const int st = b / 1024, sb = b % 1024, swz = sb ^ (((sb >> 9) & 1) << 5); R = (st >> 1) * 16 + swz / 64; C = (st & 1) * 32 + (swz % 64) / 2; }
__device__ __forceinline__ int perm32(int rho) { const int n = rho >> 4, i = rho & 15; return 8 * (i >> 2) + 4 * n + (i & 3); }
__device__ __forceinline__ int xcd_remap(int wgid, int nwg) { const int q = nwg / NXCD, r = nwg % NXCD, xcd = wgid % NXCD, off = wgid / NXCD; return (xcd < r ? xcd * (q + 1) : r * (q + 1) + (xcd - r) * q) + off; }

struct Unit { int pm, pn, e, hrow, nvalid, lbase, kt0, nt, slab; };

struct DenseSched {
    const bf16* A; const bf16* Bt; int K, nM, nN, nwg, G, c;
    __device__ void init(const bf16* A_, const bf16* Bt_, int M_, int N_, int K_, int G_, int c_) { A = A_; Bt = Bt_; K = K_; nM = M_ / BM; nN = N_ / BM; nwg = nM * nN; G = G_; c = c_; }
    __device__ __forceinline__ bool next(int i, Unit& u) const {
        const long L = (long)i * G + c; if (L >= nwg) return false;
        const int wgid = xcd_remap((int)L, nwg);
        const int nig = WGM * nN, gid = wgid / nig, fm = gid * WGM, gsz = (nM - fm) < WGM ? (nM - fm) : WGM;
        u.pm = fm + ((wgid % nig) % gsz); u.pn = (wgid % nig) / gsz; u.e = 0; u.hrow = u.pm * BM; u.nvalid = BM; u.lbase = 0; u.kt0 = 0; u.nt = K / BK; u.slab = -1; return true;
    }
    __device__ __forceinline__ const char* a_base(const Unit& u) const { return (const char*)A + (size_t)u.pm * BM * K * 2; }
    __device__ __forceinline__ const char* b_base(const Unit& u) const { return (const char*)Bt + (size_t)u.pn * BM * K * 2; }
    __device__ __forceinline__ bool late() const { return false; }
    __device__ __forceinline__ void prefetch(const Unit&, int, int) const {}
    __device__ __forceinline__ void a_voff_late(const Unit&, const int (&)[2], const int (&)[2], unsigned (&)[2][2], int) const {}
    __device__ __forceinline__ void a_voff(const Unit&, const int (&R)[2], const int (&C)[2], unsigned (&v)[2][2]) const {
#pragma unroll
        for (int h = 0; h < 2; ++h)
#pragma unroll
            for (int i = 0; i < 2; ++i) v[h][i] = (unsigned)((h * HALF + R[i]) * K + C[i]) * 2u;
    }
};
struct MoeSched {
    const bf16* A; const bf16* Bt; const unsigned* list; const volatile LAS int* tab; int K, ncol, G, c; bool gather; size_t bstride;
    LAS unsigned* lbuf;
    bool ksplit;
    __device__ __forceinline__ int T(int i) const { return __builtin_amdgcn_readfirstlane(tab[i]); }
    __device__ __forceinline__ bool split_on(int nwg) const { return ksplit && G == 256 && nwg > 2 * G && nwg - 2 * G <= G / 4 && ((K / BK) % 8) == 0; }
    __device__ __forceinline__ void decode(int wgid, Unit& u) const {
        int e = 0;
#pragma unroll
        for (int j = 1; j < 16; ++j) e += (wgid >= T(j)) ? 1 : 0;
        const int local = wgid - T(e), tiles = T(17 + e);
        const int pn = local / tiles, rt = local % tiles;
        u.e = e; u.pn = pn; u.pm = rt; u.hrow = T(33 + e) + rt * BM; const int rem = T(49 + e) - rt * BM; u.nvalid = rem < BM ? rem : BM; u.lbase = rt * BM;
    }
    __device__ __forceinline__ bool next(int i, Unit& u) const {
        const int nwg = T(65); const int ntf = K / BK;
        int wgid, kt0 = 0, ntu = ntf, slab = -1;
        if (split_on(nwg)) {
            if (i > 2) return false;
            if (i < 2) wgid = xcd_remap(i * G + c, 2 * G);
            else { wgid = 2 * G + (c >> 2); if (wgid >= nwg) return false; ntu = ntf / 4; kt0 = (c & 3) * ntu; slab = c; }
        } else { const long L = (long)i * G + c; if (L >= nwg) return false; wgid = xcd_remap((int)L, nwg); }
        decode(wgid, u); u.kt0 = kt0; u.nt = ntu; u.slab = slab; return true;
    }
    __device__ __forceinline__ const char* a_base(const Unit& u) const { return (gather ? (const char*)A : (const char*)A + (size_t)u.hrow * K * 2) + (size_t)u.kt0 * (BK * 2); }
    __device__ __forceinline__ const char* b_base(const Unit& u) const { return (const char*)Bt + (size_t)u.e * bstride + (size_t)u.pn * BM * K * 2 + (size_t)u.kt0 * (BK * 2); }
    __device__ __forceinline__ bool late() const { return gather; }
    __device__ __forceinline__ void prefetch(const Unit& u, int slot, int lane) const {
        if (gather) __builtin_amdgcn_global_load_lds((const unsigned*)(list + (size_t)u.e * M + u.lbase + 4 * lane), (LAS unsigned*)(lbuf + slot * 256), 16, 0, 0); }
    __device__ __forceinline__ void a_voff_late(const Unit& u, const int (&R)[2], const int (&C)[2], unsigned (&v)[2][2], int slot) const {
#pragma unroll
        for (int h = 0; h < 2; ++h)
#pragma unroll
            for (int i = 0; i < 2; ++i) { const int r = h * HALF + R[i]; unsigned tok = lbuf[slot * 256 + r]; tok = r < u.nvalid ? tok : 0u; v[h][i] = (tok * (unsigned)K + (unsigned)C[i]) * 2u; } }
    __device__ __forceinline__ void a_voff(const Unit& u, const int (&R)[2], const int (&C)[2], unsigned (&v)[2][2]) const {
#pragma unroll
        for (int h = 0; h < 2; ++h)
#pragma unroll
            for (int i = 0; i < 2; ++i) {
                const int r = h * HALF + R[i];
                if (gather) { const int rc = r < u.nvalid ? r : u.nvalid - 1; unsigned tok = list[(size_t)u.e * M + u.lbase + rc]; tok = r < u.nvalid ? tok : 0u; v[h][i] = (tok * (unsigned)K + (unsigned)C[i]) * 2u; }
                else v[h][i] = (unsigned)(r * K + C[i]) * 2u;
            }
    }
};

template <class Epi, class Sched>
__device__ __forceinline__ void gemm_phase(LAS unsigned char* lds, const Sched& S, const Epi& E) {
    const int tid = threadIdx.x, wid = __builtin_amdgcn_readfirstlane(tid >> 6), lane = tid & 63, wr = wid >> 2, wc = wid & 3, fr = lane & 15, fq = lane >> 4;
    const int K = S.K; int nt = K / BK;
    int Rr[2], Cc[2]; unsigned voffB[2];
#pragma unroll
    for (int i = 0; i < 2; ++i) { int R, C; stage_rc(tid * 16 + i * 8192, R, C); Rr[i] = R; Cc[i] = C; const int Rb = Epi::PERM ? ((R & ~31) + perm32(R & 31)) : R; voffB[i] = (unsigned)(Rb * K + C) * 2u; }
    const size_t kstep = (size_t)(BK * 2);
    const size_t hstep = (size_t)HALF * K * 2;
    const unsigned ldsw = (unsigned)wid * 1024u;
    const int aoff = lds_byte(wr * 64 + fr, fq * 8), boff = lds_byte(wc * 32 + fr, fq * 8);
#define PG8_SA(b, h) (((b) * 2 + (h)) * HTB)
#define PG8_SB(b, h) ((4 + (b) * 2 + (h)) * HTB)
#define PG8_STAGE(bufoff, gbase, voff) do { _Pragma("unroll") for (int _i = 0; _i < 2; ++_i) \
        __builtin_amdgcn_global_load_lds((const unsigned*)((const char*)(gbase) + (voff)[_i]), (LAS unsigned*)(lds + (bufoff) + ldsw + _i * 8192), 16, 0, 0); } while (0)
#define PG8_LDA(dst, b, h) do { _Pragma("unroll") for (int m = 0; m < 4; ++m) _Pragma("unroll") for (int k = 0; k < 2; ++k) dst[m][k] = *(const LAS bf16x8*)(lds + PG8_SA(b, h) + aoff + m * 2048 + k * 1024); } while (0)
#define PG8_LDB(dst, b, h) do { _Pragma("unroll") for (int n = 0; n < 2; ++n) _Pragma("unroll") for (int k = 0; k < 2; ++k) dst[n][k] = *(const LAS bf16x8*)(lds + PG8_SB(b, h) + boff + n * 2048 + k * 1024); } while (0)
#define PG8_MMA(ai, bj, At, Bt) do { __builtin_amdgcn_s_setprio(1); _Pragma("unroll") for (int m = 0; m < 4; ++m) _Pragma("unroll") for (int n = 0; n < 2; ++n) _Pragma("unroll") for (int k = 0; k < 2; ++k) \
        acc[ai][bj][m][n] = __builtin_amdgcn_mfma_f32_16x16x32_bf16(Bt[n][k], At[m][k], acc[ai][bj][m][n], 0, 0, 0); __builtin_amdgcn_s_setprio(0); } while (0)
#define PG8_WAIT_V(n) asm volatile("s_waitcnt vmcnt(" #n ")" ::: "memory")
#define PG8_WAIT_L(n) asm volatile("s_waitcnt lgkmcnt(" #n ")" ::: "memory")
#define PG8_BAR __builtin_amdgcn_s_barrier()
#define PG8_SCHED __builtin_amdgcn_sched_barrier(0)
    Unit cur, nxt; int ui = 0;
    if (!S.next(0, cur)) return;
    f32x4 acc[2][2][4][2];
#pragma unroll
    for (int a = 0; a < 2; ++a)
#pragma unroll
        for (int b = 0; b < 2; ++b)
#pragma unroll
            for (int m = 0; m < 4; ++m)
#pragma unroll
                for (int n = 0; n < 2; ++n) acc[a][b][m][n] = (f32x4){0.f, 0.f, 0.f, 0.f};
    bf16x8 At[4][2], B0[2][2], B1[2][2];
    unsigned vc[2][2], vn[2][2];
    S.a_voff(cur, Rr, Cc, vc); nt = cur.nt;
    const char* cA = S.a_base(cur); const char* cB = S.b_base(cur);
    PG8_STAGE(PG8_SB(0, 0), cB, voffB); PG8_STAGE(PG8_SB(0, 1), cB + hstep, voffB); PG8_STAGE(PG8_SA(0, 0), cA, vc[0]); PG8_STAGE(PG8_SA(0, 1), cA, vc[1]);
    if (wr == 1) PG8_BAR;
    PG8_WAIT_V(2); PG8_BAR;
    PG8_STAGE(PG8_SB(1, 0), cB + kstep, voffB); PG8_STAGE(PG8_SA(1, 0), cA + kstep, vc[0]); PG8_STAGE(PG8_SB(1, 1), cB + hstep + kstep, voffB);
    PG8_WAIT_V(6); PG8_BAR;
    for (;;) {
        const bool has_next = S.next(ui + 1, nxt);
        const char* nA = has_next ? S.a_base(nxt) : cA; const char* nB = has_next ? S.b_base(nxt) : cB;
        if (has_next && S.late()) S.prefetch(nxt, ui & 1, lane);
        else if (has_next) S.a_voff(nxt, Rr, Cc, vn);
        else {
#pragma unroll
            for (int h = 0; h < 2; ++h)
#pragma unroll
                for (int i = 0; i < 2; ++i) vn[h][i] = vc[h][i]; }
        for (int t = 0; t < nt; t += 2) {
            const bool last = (t == nt - 2);
            const char* a1 = cA + (size_t)(t + 1) * kstep;
            const char* a2 = last ? nA : cA + (size_t)(t + 2) * kstep; const char* b2 = last ? nB : cB + (size_t)(t + 2) * kstep;
            const char* a3 = a2 + kstep; const char* b3 = b2 + kstep;
            if (last && has_next && S.late()) S.a_voff_late(nxt, Rr, Cc, vn, ui & 1);
            unsigned vx[2][2];
#pragma unroll
            for (int h = 0; h < 2; ++h)
#pragma unroll
                for (int i = 0; i < 2; ++i) vx[h][i] = last ? vn[h][i] : vc[h][i];
            PG8_LDB(B0, 0, 0); PG8_LDB(B1, 0, 1); PG8_SCHED; PG8_LDA(At, 0, 0); PG8_STAGE(PG8_SA(1, 1), a1, vc[1]);
            PG8_WAIT_V(8); PG8_WAIT_L(0); PG8_BAR; PG8_MMA(0, 0, At, B0); PG8_MMA(0, 1, At, B1); PG8_BAR; PG8_SCHED;
            PG8_LDA(At, 0, 1); PG8_STAGE(PG8_SB(0, 0), b2, voffB); PG8_STAGE(PG8_SB(0, 1), b2 + hstep, voffB); PG8_STAGE(PG8_SA(0, 0), a2, vx[0]);
            PG8_WAIT_V(8); PG8_WAIT_L(0); PG8_BAR; PG8_MMA(1, 0, At, B0); PG8_MMA(1, 1, At, B1); PG8_BAR; PG8_SCHED;
            PG8_LDB(B0, 1, 0); PG8_LDB(B1, 1, 1); PG8_SCHED; PG8_LDA(At, 1, 0); PG8_STAGE(PG8_SA(0, 1), a2, vx[1]);
            PG8_WAIT_V(8); PG8_WAIT_L(0); PG8_BAR; PG8_MMA(0, 0, At, B0); PG8_MMA(0, 1, At, B1); PG8_BAR; PG8_SCHED;
            PG8_LDA(At, 1, 1); PG8_STAGE(PG8_SB(1, 0), b3, voffB); PG8_STAGE(PG8_SB(1, 1), b3 + hstep, voffB); PG8_STAGE(PG8_SA(1, 0), a3, vx[0]);
            PG8_WAIT_V(8); PG8_WAIT_L(0); PG8_BAR; PG8_MMA(1, 0, At, B0); PG8_MMA(1, 1, At, B1); PG8_BAR; PG8_SCHED;
        }
        if (wr == 0) PG8_BAR;
        E(acc, cur, wr, wc, fr, fq);
        if (!has_next) break;
#pragma unroll
        for (int a = 0; a < 2; ++a)
#pragma unroll
            for (int b = 0; b < 2; ++b)
#pragma unroll
                for (int m = 0; m < 4; ++m)
#pragma unroll
                    for (int n = 0; n < 2; ++n) acc[a][b][m][n] = (f32x4){0.f, 0.f, 0.f, 0.f};
        cur = nxt; cA = nA; cB = nB; ++ui; nt = cur.nt;
#pragma unroll
        for (int h = 0; h < 2; ++h)
#pragma unroll
            for (int i = 0; i < 2; ++i) vc[h][i] = vn[h][i];
        if (wr == 1) PG8_BAR;
    }
    PG8_WAIT_V(0);
    PG8_BAR;
#undef PG8_SA
#undef PG8_SB
#undef PG8_STAGE
#undef PG8_LDA
#undef PG8_LDB
#undef PG8_MMA
#undef PG8_WAIT_V
#undef PG8_WAIT_L
#undef PG8_BAR
#undef PG8_SCHED
}

__device__ __forceinline__ float gelu_tanh(float x) { const float y = 1.5957691216f * (x + 0.044715f * x * x * x); return x * __builtin_amdgcn_rcpf(1.0f + __builtin_amdgcn_exp2f(-1.44269504089f * y)); }
struct EpiGeluUV {
    static constexpr bool PERM = true;
    bf16* U; bf16* V; f32x2* vstat;
    __device__ __forceinline__ void operator()(const f32x4 (&acc)[2][2][4][2], const Unit& u, int wr, int wc, int fr, int fq) const {
        const bool isv = u.pn >= 12; const int ct = isv ? u.pn - 12 : u.pn;
        bf16* base = isv ? V : U;
        const int row0 = u.pm * BM + wr * 64 + fr, col0 = ct * BM + wc * 32 + 8 * fq;
#pragma unroll
        for (int ai = 0; ai < 2; ++ai)
#pragma unroll
            for (int m = 0; m < 4; ++m) { const int row = row0 + ai * HALF + m * 16; bf16* rowp = base + (size_t)row * AIN + col0; float s1 = 0.f, s2 = 0.f;
#pragma unroll
                for (int bj = 0; bj < 2; ++bj) { f32x4 v0 = acc[ai][bj][m][0], v1 = acc[ai][bj][m][1];
#pragma unroll
                    for (int j = 0; j < 4; ++j) { v0[j] = gelu_tanh(v0[j]); v1[j] = gelu_tanh(v1[j]); s1 += v0[j] + v1[j]; s2 += v0[j] * v0[j] + v1[j] * v1[j]; }
                    u32x4 w; w.x = cvt_pk_bf16(v0[0], v0[1]); w.y = cvt_pk_bf16(v0[2], v0[3]); w.z = cvt_pk_bf16(v1[0], v1[1]); w.w = cvt_pk_bf16(v1[2], v1[3]);
                    *(u32x4*)(rowp + bj * HALF) = w; }
                if (isv) { s1 += __shfl_xor(s1, 16); s1 += __shfl_xor(s1, 32); s2 += __shfl_xor(s2, 16); s2 += __shfl_xor(s2, 32);
                    if (fq == 0) vstat[(size_t)row * 48 + ct * 4 + wc] = (f32x2){s1, s2}; } }
    }
};
struct EpiResid {
    static constexpr bool PERM = false;
    const float* base; float* out; const float* gate;
    __device__ __forceinline__ void operator()(const f32x4 (&acc)[2][2][4][2], const Unit& u, int wr, int wc, int fr, int fq) const {
        const int row0 = u.pm * BM + wr * 64 + fr, col0 = u.pn * BM + wc * 32 + 4 * fq; const int b = (u.pm * BM) / SEQ;
        f32x4 gv[2][2];
#pragma unroll
        for (int bj = 0; bj < 2; ++bj)
#pragma unroll
            for (int n = 0; n < 2; ++n) gv[bj][n] = *(const f32x4*)(gate + b * 6144 + col0 + bj * HALF + n * 16);
#pragma unroll
        for (int ai = 0; ai < 2; ++ai)
#pragma unroll
            for (int m = 0; m < 4; m += 2) { const size_t off = (size_t)(row0 + ai * HALF + m * 16) * D + col0;
                f32x4 bs[2][2][2];
#pragma unroll
                for (int mm = 0; mm < 2; ++mm)
#pragma unroll
                    for (int bj = 0; bj < 2; ++bj)
#pragma unroll
                        for (int n = 0; n < 2; ++n) bs[mm][bj][n] = *(const f32x4*)(base + off + (size_t)mm * 16 * D + bj * HALF + n * 16);
#pragma unroll
                for (int mm = 0; mm < 2; ++mm)
#pragma unroll
                    for (int bj = 0; bj < 2; ++bj)
#pragma unroll
                        for (int n = 0; n < 2; ++n) *(f32x4*)(out + off + (size_t)mm * 16 * D + bj * HALF + n * 16) = bs[mm][bj][n] + gv[bj][n] * acc[ai][bj][m + mm][n]; }
    }
};
struct EpiF32 {
    static constexpr bool PERM = false;
    float* C; int ldc; float* slabs;
    __device__ __forceinline__ void operator()(const f32x4 (&acc)[2][2][4][2], const Unit& u, int wr, int wc, int fr, int fq) const {
        const bool sp = u.slab >= 0;
        const int row0 = (sp ? 0 : u.hrow) + wr * 64 + fr, col0 = (sp ? 0 : u.pn * BM) + wc * 32 + 4 * fq; const int ld = sp ? BM : ldc;
        float* base = sp ? slabs + (size_t)u.slab * (BM * BM) : C;
#pragma unroll
        for (int ai = 0; ai < 2; ++ai)
#pragma unroll
            for (int m = 0; m < 4; ++m) { float* rowp = base + (size_t)(row0 + ai * HALF + m * 16) * ld + col0;
#pragma unroll
                for (int bj = 0; bj < 2; ++bj)
#pragma unroll
                    for (int n = 0; n < 2; ++n) *(f32x4*)(rowp + bj * HALF + n * 16) = acc[ai][bj][m][n]; }
    }
};
struct EpiSwiGLU {
    static constexpr bool PERM = true;
    bf16* H;
    __device__ __forceinline__ void operator()(const f32x4 (&acc)[2][2][4][2], const Unit& u, int wr, int wc, int fr, int fq) const {
        const int row0 = u.hrow + wr * 64 + fr, col0 = u.pn * HALF + wc * 32 + 8 * fq;
#pragma unroll
        for (int ai = 0; ai < 2; ++ai)
#pragma unroll
            for (int m = 0; m < 4; ++m) { bf16* rowp = H + (size_t)(row0 + ai * HALF + m * 16) * DE + col0;
                f32x4 v0, v1;
#pragma unroll
                for (int j = 0; j < 4; ++j) { const float g0 = acc[ai][0][m][0][j], g1 = acc[ai][0][m][1][j];
                    v0[j] = g0 * sigmoidf_(g0) * acc[ai][1][m][0][j]; v1[j] = g1 * sigmoidf_(g1) * acc[ai][1][m][1][j]; }
                u32x4 w; w.x = cvt_pk_bf16(v0[0], v0[1]); w.y = cvt_pk_bf16(v0[2], v0[3]); w.z = cvt_pk_bf16(v1[0], v1[1]); w.w = cvt_pk_bf16(v1[2], v1[3]);
                *(u32x4*)rowp = w; }
    }
};
struct EpiYbf {
    static constexpr bool PERM = true;
    bf16* Y; bf16* slabs;
    __device__ __forceinline__ void operator()(const f32x4 (&acc)[2][2][4][2], const Unit& u, int wr, int wc, int fr, int fq) const {
        const bool sp = u.slab >= 0;
        bf16* base = sp ? slabs + (size_t)u.slab * (BM * BM) : Y + (size_t)u.hrow * D + u.pn * BM;
        const int ld = sp ? BM : D;
        base += (size_t)(wr * 64 + fr) * ld + wc * 32 + 8 * fq;
#pragma unroll
        for (int ai = 0; ai < 2; ++ai)
#pragma unroll
            for (int m = 0; m < 4; ++m) { bf16* rowp = base + (size_t)(ai * HALF + m * 16) * ld;
#pragma unroll
                for (int bj = 0; bj < 2; ++bj) { const f32x4 v0 = acc[ai][bj][m][0], v1 = acc[ai][bj][m][1];
                    *(u32x4*)(rowp + bj * HALF) = (u32x4){cvt_pk_bf16(v0[0], v0[1]), cvt_pk_bf16(v0[2], v0[3]), cvt_pk_bf16(v1[0], v1[1]), cvt_pk_bf16(v1[2], v1[3])}; } }
    }
};
}

struct Args { const float* in[25]; float* out; unsigned char* ws; int ph_lo, ph_hi; };
enum { I_X = 0, I_C, I_ADAW, I_ADAB, I_N1G, I_N2G, I_AWIN, I_ALNG, I_ALNB, I_AWSP, I_ABSP, I_AWOUT, I_BWIN, I_BKVG, I_BWUK, I_BWUV, I_BKIG, I_BWOUT, I_RELB, I_RW, I_RB, I_WG, I_WU, I_WDN, I_FG };

__device__ __forceinline__ unsigned f2bf(float f) { unsigned u = __builtin_bit_cast(unsigned, f); return (u + 0x7fffu + ((u >> 16) & 1u)) >> 16; }
__device__ __forceinline__ unsigned pk2(float lo, float hi) { return f2bf(lo) | (f2bf(hi) << 16); }
template <bool NT = false, class DRow>
__device__ __forceinline__ void transpose_item(const float* W, int K, int N, bf16* WT, LAS float* scr, int item, int nblk, int lane, DRow drow) {
    const int kb = item / nblk, nb = item % nblk, k0 = 64 * kb, n0 = 32 * nb;
    const int nn = n0 + (lane & 31); const bool ok = nn < N;
    if constexpr (NT) {
#pragma unroll 8
    for (int i = 0; i < 32; ++i) { const int kk = 2 * i + (lane >> 5); scr[kk * 33 + (lane & 31)] = ok ? (NT ? __builtin_nontemporal_load(W + (size_t)(k0 + kk) * N + nn) : W[(size_t)(k0 + kk) * N + nn]) : 0.f; }
    } else {
#pragma unroll
    for (int i = 0; i < 32; ++i) { const int kk = 2 * i + (lane >> 5); scr[kk * 33 + (lane & 31)] = ok ? (NT ? __builtin_nontemporal_load(W + (size_t)(k0 + kk) * N + nn) : W[(size_t)(k0 + kk) * N + nn]) : 0.f; }
    }
    LDS_WAIT(); asm volatile("" ::: "memory");
    const int c = lane & 7;
#pragma unroll
    for (int j = 0; j < 4; ++j) { const int n = (lane >> 3) + 8 * j; const LAS float* s = scr + (8 * c) * 33 + n;
        u32x4 o; o.x = pk2(s[0 * 33], s[1 * 33]); o.y = pk2(s[2 * 33], s[3 * 33]); o.z = pk2(s[4 * 33], s[5 * 33]); o.w = pk2(s[6 * 33], s[7 * 33]);
        if (NT) __builtin_nontemporal_store(o, (GAS u32x4*)(WT + (size_t)drow(n0 + n) * K + k0 + 8 * c)); else *(GAS u32x4*)(WT + (size_t)drow(n0 + n) * K + k0 + 8 * c) = o; }
    LDS_WAIT(); asm volatile("" ::: "memory");
}
template <bool NT>
__device__ __forceinline__ void moe_transpose(const Args& a, LAS float* scr, int idx, int layer, int lane) {
    unsigned char* ws = a.ws; const int mat = idx / 1792, item = idx % 1792, which = mat >> 4, le = layer * 16 + (mat & 15);
    if (which == 0) transpose_item<NT>(a.in[I_WG] + (size_t)le * D * DE, D, DE, (bf16*)(ws + WS_WGU) + (size_t)le * NGU * D, scr, item, DE / 32, lane, [](int n) { return (n >> 7) * 256 + (n & 127); });
    else if (which == 1) transpose_item<NT>(a.in[I_WU] + (size_t)le * D * DE, D, DE, (bf16*)(ws + WS_WGU) + (size_t)le * NGU * D, scr, item, DE / 32, lane, [](int n) { return (n >> 7) * 256 + 128 + (n & 127); });
    else transpose_item<NT>(a.in[I_WDN] + (size_t)le * DE * D, DE, D, (bf16*)(ws + WS_WD) + (size_t)le * D * DE, scr, item, D / 32, lane, [](int n) { return n; });
}
__device__ __forceinline__ void p0_prologue(const Args& a, LAS unsigned char* lds, int gw, int NGW, int wave, int lane) {
    unsigned char* ws = a.ws;
    LAS float* scr = (LAS float*)(lds + wave * 16384);
    for (int it = gw; it < 2 * 96 * 8; it += NGW) {
        const int ks = it & 7, cc = (it >> 3) % 96, l = it / 768, k0 = ks * 128, col = cc * 64 + lane;
#pragma unroll
        for (int b = 0; b < 4; ++b)
#pragma unroll
            for (int j = 0; j < 2; ++j) { const float v = a.in[I_C][b * D + k0 + j * 64 + lane]; scr[b * 128 + j * 64 + lane] = v * sigmoidf_(v); }
        LDS_WAIT(); asm volatile("" ::: "memory");
        const float* W = a.in[I_ADAW] + ((size_t)l * D + k0) * 6144 + col;
        float a0 = 0.f, a1 = 0.f, a2 = 0.f, a3 = 0.f;
#pragma unroll
        for (int h = 0; h < 2; ++h) {
            float wv[64];
#pragma unroll
            for (int k = 0; k < 64; ++k) wv[k] = W[(size_t)(h * 64 + k) * 6144];
            __builtin_amdgcn_sched_barrier(0);
#pragma unroll
            for (int k = 0; k < 64; ++k) { const int kk = h * 64 + k; const float w = wv[k]; a0 += scr[kk] * w; a1 += scr[128 + kk] * w; a2 += scr[256 + kk] * w; a3 += scr[384 + kk] * w; }
            __builtin_amdgcn_sched_barrier(0);
        }
        float* mp = (float*)(ws + WS_MODP) + (size_t)ks * 49152 + (size_t)l * 24576 + col;
        mp[0] = a0; mp[6144] = a1; mp[2 * 6144] = a2; mp[3 * 6144] = a3;
        LDS_WAIT(); asm volatile("" ::: "memory");
    }
    {
        const int gt = gw * 64 + lane, NT = NGW * 64;
        bf16* wuk = (bf16*)(ws + WS_WUK); bf16* wuvt = (bf16*)(ws + WS_WUVT); bf16* wsp = (bf16*)(ws + WS_WSP);
        for (int i = gt; i < CL * NH * HD; i += NT) wuk[i] = (bf16)f2bf(a.in[I_BWUK][i]);
        for (int i = gt; i < CL * NH * HD; i += NT) { const int c = i & 255, d = (i >> 8) & 63, h = i >> 14; wuvt[i] = (bf16)f2bf(a.in[I_BWUV][(c * NH + h) * HD + d]); }
        for (int i = gt; i < NGRP * CHUNK * CHUNK; i += NT) { const int s = i & 127, t = (i >> 7) & 127; wsp[i] = (s <= t) ? (bf16)f2bf(a.in[I_AWSP][i]) : (bf16)0; }
    }
    constexpr int I_A1 = 16 * 192, I_A2 = 48 * 32, I_B1 = 16 * 64, I_B2 = 16 * 32, I_M = 1792;
    constexpr int NSMALL = I_A1 + I_A2 + I_B1 + I_B2;
    const int NITEMS = NSMALL;
    for (int it = gw; it < NITEMS; it += NGW) {
        int r = it;
        if (r < I_A1) { transpose_item(a.in[I_AWIN], D, NZ, (bf16*)(ws + WS_WINA), scr, r, NZ / 32, lane, [](int n) { return n; }); continue; } r -= I_A1;
        if (r < I_A2) { transpose_item(a.in[I_AWOUT], AIN, D, (bf16*)(ws + WS_WOUTA), scr, r, D / 32, lane, [](int n) { return n; }); continue; } r -= I_A2;
        if (r < I_B1) { transpose_item(a.in[I_BWIN], D, BPROJ, (bf16*)(ws + WS_WINB), scr, r, NPROJ / 32, lane, [](int n) { return n; }); continue; } r -= I_B1;
        if (r < I_B2) { transpose_item(a.in[I_BWOUT], D, D, (bf16*)(ws + WS_WOUTB), scr, r, D / 32, lane, [](int n) { return n; }); continue; } r -= I_B2;
        moe_transpose<false>(a, scr, r, 0, lane);
    }
}

__device__ __forceinline__ float mod_val(const Args& a, bool partials, int l, int b, int j) {
    if (!partials) return ((const float*)(a.ws + WS_MODF))[(l * 4 + b) * 6144 + j];
    float s = a.in[I_ADAB][l * 6144 + j]; const float* mp = (const float*)(a.ws + WS_MODP) + (size_t)(l * 4 + b) * 6144 + j;
#pragma unroll
    for (int ks = 0; ks < 8; ++ks) s += mp[(size_t)ks * 49152];
    return s;
}
__device__ __forceinline__ void load_norm_vecs(const Args& a, bool partials, int l, int b, int shift_part, const float* g, LAS float* vsc, LAS float* vsh) {
    for (int d = threadIdx.x; d < D; d += NTHR) { vsc[d] = g[d] * (1.0f + mod_val(a, partials, l, b, (shift_part + 1) * 1024 + d)); vsh[d] = mod_val(a, partials, l, b, shift_part * 1024 + d); }
}
__device__ __forceinline__ void rms_mod_row(f32x4 (&v)[4], const LAS float* vsc, const LAS float* vsh, int lane) {
    float s = 0.f;
#pragma unroll
    for (int j = 0; j < 4; ++j) s += (v[j].x * v[j].x + v[j].y * v[j].y) + (v[j].z * v[j].z + v[j].w * v[j].w);
    const float rstd = 1.0f / sqrtf(wave_sum(s) * (1.0f / D) + EPS);
#pragma unroll
    for (int j = 0; j < 4; ++j) { const f32x4 c = *(const LAS f32x4*)(vsc + 4 * lane + 256 * j), h = *(const LAS f32x4*)(vsh + 4 * lane + 256 * j); v[j] = v[j] * rstd * c + h; }
}
__device__ __forceinline__ void store_row_bf16(const f32x4 (&v)[4], bf16* orow, int lane) {
    GAS u32x2* o8 = (GAS u32x2*)orow + lane;
#pragma unroll
    for (int j = 0; j < 4; ++j) o8[64 * j] = (u32x2){cvt_pk_bf16(v[j].x, v[j].y), cvt_pk_bf16(v[j].z, v[j].w)};
}

__device__ __forceinline__ bf16x4 lds_tr16(const LAS unsigned char* p) { return __builtin_bit_cast(bf16x4, __builtin_amdgcn_ds_read_tr16_b64_v4i16((LAS v4i16_t*)p)); }
constexpr int SG_STRIDE = 800;
struct CvItem { const float* src; bf16* dst; int N, K, n0, radd; bool plain; };
__device__ __forceinline__ CvItem cv_item(const Args& a, int idx, int layer) {
    unsigned char* ws = a.ws; const int mat = idx / 1792, item = idx % 1792, which = mat >> 4, le = layer * 16 + (mat & 15);
    CvItem c;
    if (which == 2) { const int kb = item >> 5, nb = item & 31; c.N = D; c.K = DE; c.n0 = 32 * nb; c.src = a.in[I_WDN] + (size_t)le * DE * D + (size_t)(64 * kb) * D + c.n0; c.dst = (bf16*)(ws + WS_WD) + (size_t)le * D * DE + 64 * kb; c.plain = true; c.radd = 0; }
    else { const int kb = item / 112, nb = item % 112; c.N = DE; c.K = D; c.n0 = 32 * nb; c.src = (which ? a.in[I_WU] : a.in[I_WG]) + (size_t)le * D * DE + (size_t)(64 * kb) * DE + c.n0; c.dst = (bf16*)(ws + WS_WGU) + (size_t)le * NGU * D + 64 * kb; c.plain = false; c.radd = which ? 128 : 0; }
    return c;
}
__device__ __forceinline__ void cv_load(const CvItem& c, int lane, float (&r)[32]) {
#pragma unroll
    for (int i = 0; i < 32; ++i) { const unsigned off = (unsigned)(((2 * i + (lane >> 5)) * c.N + (lane & 31)) * 4); r[i] = __builtin_nontemporal_load((const float*)((const char*)c.src + off)); }
}
__device__ __forceinline__ void cv_finish(const CvItem& c, LAS float* scr, int lane, const float (&r)[32]) {
    unsigned d[16];
#pragma unroll
    for (int m = 0; m < 16; ++m) {
        const auto sw = __builtin_amdgcn_permlane32_swap(__builtin_bit_cast(unsigned, r[m]), __builtin_bit_cast(unsigned, r[16 + m]), false, false);
        d[m] = cvt_pk_bf16(__builtin_bit_cast(float, (unsigned)sw[0]), __builtin_bit_cast(float, (unsigned)sw[1]));
    }
    LAS unsigned char* sb = (LAS unsigned char*)scr;
    LAS u32x4* wp = (LAS u32x4*)(sb + (lane & 31) * 144 + (lane >> 5) * 64);
#pragma unroll
    for (int q = 0; q < 4; ++q) wp[q] = (u32x4){d[4 * q], d[4 * q + 1], d[4 * q + 2], d[4 * q + 3]};
    LDS_WAIT(); asm volatile("" ::: "memory");
    const int c8 = lane & 7;
#pragma unroll
    for (int j = 0; j < 4; ++j) { const int n = (lane >> 3) + 8 * j;
        const u32x4 o = *(const LAS u32x4*)(sb + n * 144 + c8 * 16);
        const int nn = c.n0 + n, dr = c.plain ? nn : (nn >> 7) * 256 + c.radd + (nn & 127);
        __builtin_nontemporal_store(o, (GAS u32x4*)(c.dst + (size_t)dr * c.K + 8 * c8)); }
    LDS_WAIT(); asm volatile("" ::: "memory");
}
__device__ __forceinline__ void cv_batch3(const Args& a, LAS float* scr, int idx0, int stride, int layer, int lane) {
    const int total = 3 * 16 * 1792;
    if (idx0 + 2 * stride < total) {
        const CvItem c0 = cv_item(a, idx0, layer), c1 = cv_item(a, idx0 + stride, layer), c2 = cv_item(a, idx0 + 2 * stride, layer);
        float R0[32], R1[32], R2[32];
        __builtin_amdgcn_sched_barrier(0);
        cv_load(c0, lane, R0); cv_load(c1, lane, R1); cv_load(c2, lane, R2);
        __builtin_amdgcn_sched_barrier(0);
        cv_finish(c0, scr, lane, R0); cv_finish(c1, scr, lane, R1); cv_finish(c2, scr, lane, R2);
    } else {
#pragma unroll 1
        for (int k = 0; k < 3; ++k) { const int idx = idx0 + k * stride; if (idx < total) { const CvItem c0 = cv_item(a, idx, layer); float R0[32]; cv_load(c0, lane, R0); cv_finish(c0, scr, lane, R0); } }
    }
}
__device__ __forceinline__ CvItem cv64_item(const Args& a, int idx, int layer) {
    unsigned char* ws = a.ws; const int mat = idx / 896, item = idx % 896, which = mat >> 4, le = layer * 16 + (mat & 15);
    CvItem c;
    if (which == 2) { const int kb = item >> 4, nb = item & 15; c.N = D; c.K = DE; c.n0 = 64 * nb; c.src = a.in[I_WDN] + (size_t)le * DE * D + (size_t)(64 * kb) * D + c.n0; c.dst = (bf16*)(ws + WS_WD) + (size_t)le * D * DE + 64 * kb; c.plain = true; c.radd = 0; }
    else { const int kb = item / 56, nb = item % 56; c.N = DE; c.K = D; c.n0 = 64 * nb; c.src = (which ? a.in[I_WU] : a.in[I_WG]) + (size_t)le * D * DE + (size_t)(64 * kb) * DE + c.n0; c.dst = (bf16*)(ws + WS_WGU) + (size_t)le * NGU * D + 64 * kb; c.plain = false; c.radd = which ? 128 : 0; }
    return c;
}
__device__ __forceinline__ void cv64_load(const CvItem& c, int lane, float (&r)[64]) {
#pragma unroll
    for (int i = 0; i < 64; ++i) { const unsigned off = (unsigned)((i * c.N + lane) * 4); r[i] = __builtin_nontemporal_load((const float*)((const char*)c.src + off)); }
}
__device__ __forceinline__ void cv64_finish(const CvItem& c, LAS float* scr, int lane, const float (&r)[64]) {
    LAS unsigned char* sb = (LAS unsigned char*)scr;
    LAS u32x4* wp = (LAS u32x4*)(sb + lane * 144);
#pragma unroll
    for (int q = 0; q < 8; ++q) wp[q] = (u32x4){cvt_pk_bf16(r[8 * q], r[8 * q + 1]), cvt_pk_bf16(r[8 * q + 2], r[8 * q + 3]), cvt_pk_bf16(r[8 * q + 4], r[8 * q + 5]), cvt_pk_bf16(r[8 * q + 6], r[8 * q + 7])};
    LDS_WAIT(); asm volatile("" ::: "memory");
    const int c8 = lane & 7;
#pragma unroll
    for (int j = 0; j < 8; ++j) { const int n = (lane >> 3) + 8 * j;
        const u32x4 o = *(const LAS u32x4*)(sb + n * 144 + c8 * 16);
        const int nn = c.n0 + n, dr = c.plain ? nn : (nn >> 7) * 256 + c.radd + (nn & 127);
        __builtin_nontemporal_store(o, (GAS u32x4*)(c.dst + (size_t)dr * c.K + 8 * c8)); }
    LDS_WAIT(); asm volatile("" ::: "memory");
}
__device__ __forceinline__ void cv64_batch3(const Args& a, LAS float* scr, int idx0, int stride, int layer, int lane) {
    const int total = 3 * 16 * 896;
    if (idx0 + 2 * stride < total) {
        const CvItem c0 = cv64_item(a, idx0, layer), c1 = cv64_item(a, idx0 + stride, layer), c2 = cv64_item(a, idx0 + 2 * stride, layer);
        { float R0[64], R1[64];
          __builtin_amdgcn_sched_barrier(0);
          cv64_load(c0, lane, R0); cv64_load(c1, lane, R1);
          __builtin_amdgcn_sched_barrier(0);
          cv64_finish(c0, scr, lane, R0); cv64_finish(c1, scr, lane, R1); }
        __builtin_amdgcn_sched_barrier(0);
        { float R2[64]; cv64_load(c2, lane, R2); cv64_finish(c2, scr, lane, R2); }
    } else {
#pragma unroll 1
        for (int k = 0; k < 3; ++k) { const int idx = idx0 + k * stride; if (idx < total) { const CvItem c0 = cv64_item(a, idx, layer); float R0[64]; cv64_load(c0, lane, R0); cv64_finish(c0, scr, lane, R0); } }
    }
}
__device__ __forceinline__ void spatial_phase(const Args& a, LAS unsigned char* lds, int G, int vcu) {
    const int tid = threadIdx.x, lane = tid & 63, wid = __builtin_amdgcn_readfirstlane(tid >> 6), fr = lane & 15, fq = lane >> 4;
    unsigned char* ws = a.ws;
    const bf16* U = (const bf16*)(ws + WS_U); const bf16* V = (const bf16*)(ws + WS_V); bf16* S = (bf16*)(ws + WS_S);
    const f32x2* vstat = (const f32x2*)(ws + WS_VSTAT); const bf16* wsp = (const bf16*)(ws + WS_WSP);
    LAS unsigned char* vt = lds;
    LAS float* mu = (LAS float*)(lds + 102400); LAS float* rs = mu + 128;
    LAS float* lg = rs + 128; LAS float* lb = lg + GW;
    for (int unit = vcu; unit < 128 * NGRP; unit += G) {
        const int grp = unit & 7, chunk = unit >> 3, row0 = chunk * CHUNK, c0 = grp * GW;
        __syncthreads();
        if (tid < 128) { const GAS f32x4* p4 = (const GAS f32x4*)(vstat + (size_t)(row0 + tid) * 48); float s1 = 0.f, s2 = 0.f;
            f32x4 q4[24];
#pragma unroll
            for (int j = 0; j < 24; ++j) q4[j] = p4[j];
#pragma unroll
            for (int j = 0; j < 24; ++j) { s1 += q4[j].x + q4[j].z; s2 += q4[j].y + q4[j].w; }
            const float m = s1 * (1.0f / AIN), var = s2 * (1.0f / AIN) - m * m; mu[tid] = m; rs[tid] = 1.0f / sqrtf(fmaxf(var, 0.f) + EPS); }
        for (int i = tid; i < GW; i += NTHR) { lg[i] = a.in[I_ALNG][c0 + i]; lb[i] = a.in[I_ALNB][c0 + i]; }
        __syncthreads();
        bf16x8 Yf[20];
#pragma unroll
        for (int ks = 0; ks < 4; ++ks)
#pragma unroll
            for (int mt = 2 * ks; mt < 8; ++mt) Yf[(ks == 0 ? 0 : ks == 1 ? 8 : ks == 2 ? 14 : 18) + mt - 2 * ks] = *(const GAS bf16x8*)(wsp + ((size_t)grp * CHUNK + 16 * mt + fr) * CHUNK + 32 * ks + 8 * fq);
#pragma unroll 1
        for (int i0 = 0; i0 < 12; i0 += 6) {
        u32x4 rawv[6];
#pragma unroll
        for (int i = 0; i < 6; ++i) { const int ch = tid + (i0 + i) * NTHR, s = ch / 48, cc = ch % 48; rawv[i] = *(const GAS u32x4*)(V + (size_t)(row0 + s) * AIN + c0 + cc * 8); }
#pragma unroll
        for (int i = 0; i < 6; ++i) { const int ch = tid + (i0 + i) * NTHR, s = ch / 48, cc = ch % 48;
            const u32x4 raw = rawv[i];
            const float m = mu[s], r = rs[s]; const LAS float* g8 = lg + cc * 8; const LAS float* b8 = lb + cc * 8;
            float x[8] = {bflo(raw.x), bfhi(raw.x), bflo(raw.y), bfhi(raw.y), bflo(raw.z), bfhi(raw.z), bflo(raw.w), bfhi(raw.w)};
#pragma unroll
            for (int j = 0; j < 8; ++j) x[j] = (x[j] - m) * r * g8[j] + b8[j];
            u32x4 w; w.x = cvt_pk_bf16(x[0], x[1]); w.y = cvt_pk_bf16(x[2], x[3]); w.z = cvt_pk_bf16(x[4], x[5]); w.w = cvt_pk_bf16(x[6], x[7]);
            *(LAS u32x4*)(vt + s * SG_STRIDE + cc * 16) = w; }
        }
        __syncthreads();
        f32x4 acc[8][3];
#pragma unroll
        for (int mt = 0; mt < 8; ++mt)
#pragma unroll
            for (int n = 0; n < 3; ++n) acc[mt][n] = (f32x4){0.f, 0.f, 0.f, 0.f};
        const int q = fr >> 2, p = fr & 3;
#pragma unroll
        for (int ks = 0; ks < 4; ++ks) {
            bf16x8 X[3];
#pragma unroll
            for (int n = 0; n < 3; ++n) { const LAS unsigned char* bp = vt + (32 * ks + 8 * fq + q) * SG_STRIDE + (48 * wid + 16 * n + 4 * p) * 2;
                const bf16x4 lo = lds_tr16(bp), hi = lds_tr16(bp + 4 * SG_STRIDE);
                X[n] = (bf16x8){lo[0], lo[1], lo[2], lo[3], hi[0], hi[1], hi[2], hi[3]}; }
#pragma unroll
            for (int mt = 2 * ks; mt < 8; ++mt) {
                const bf16x8 Y = Yf[(ks == 0 ? 0 : ks == 1 ? 8 : ks == 2 ? 14 : 18) + mt - 2 * ks];
#pragma unroll
                for (int n = 0; n < 3; ++n) acc[mt][n] = __builtin_amdgcn_mfma_f32_16x16x32_bf16(X[n], Y, acc[mt][n], 0, 0, 0);
            }
        }
#pragma unroll
        for (int mt = 0; mt < 8; ++mt) { const int t = 16 * mt + fr; const float bs = a.in[I_ABSP][grp * CHUNK + t];
#pragma unroll
            for (int n = 0; n < 3; ++n) { const size_t off = (size_t)(row0 + t) * AIN + c0 + 48 * wid + 16 * n + 4 * fq;
                const u32x2 uu = *(const GAS u32x2*)(U + off); const f32x4 x = acc[mt][n];
                *(GAS u32x2*)(S + off) = (u32x2){cvt_pk_bf16(bflo(uu.x) * (x[0] + bs), bfhi(uu.x) * (x[1] + bs)), cvt_pk_bf16(bflo(uu.y) * (x[2] + bs), bfhi(uu.y) * (x[3] + bs))}; } }
        __syncthreads();
        { const int uidx = (unit - vcu) / G, NGW = G * NWAVES, gwv = vcu * NWAVES + wid;
          LAS float* cscr = (LAS float*)(lds + wid * 9216);
#pragma unroll 1
          for (int k0 = 0; k0 < 6; k0 += 3) cv64_batch3(a, cscr, (uidx * 6 + k0) * NGW + gwv, NGW, 0, lane); }
    }
    __syncthreads();
}


__device__ __forceinline__ void router_phase(const Args& a, LAS unsigned char* lds, int layer, const float* hin, int vcu) {
    const int tid = threadIdx.x, lane = tid & 63, wid = __builtin_amdgcn_readfirstlane(tid >> 6);
    unsigned char* ws = a.ws;
    LAS float* rw = (LAS float*)lds;
    LAS float* vsc = (LAS float*)(lds + 65536); LAS float* vsh = vsc + D;
    LAS int* ent = (LAS int*)(lds + 65536 + 8192);
    LAS int* lrank = ent + 128; LAS int* lbase = lrank + 128;
    LAS float* gts = (LAS float*)(lbase + 16);
    const int row0 = vcu * 64, b = row0 / SEQ;
    for (int i = tid; i < D * NE; i += NTHR) rw[(i & 15) * D + (i >> 4)] = a.in[I_RW][i];
    load_norm_vecs(a, false, layer, b, 3, a.in[I_N2G] + layer * D, vsc, vsh);
    __syncthreads();
    bf16* HN = (bf16*)(ws + WS_HN);
    f32x4 vv[8][4];
#pragma unroll
    for (int i = 0; i < 8; ++i) { const GAS f32x4* xr = (const GAS f32x4*)(hin + (size_t)(row0 + wid * 8 + i) * D) + lane;
#pragma unroll
        for (int j = 0; j < 4; ++j) vv[i][j] = xr[64 * j]; }
#pragma unroll
    for (int i = 0; i < 8; ++i) {
        const int lr = wid * 8 + i, row = row0 + lr;
        f32x4 (&v)[4] = vv[i];
        rms_mod_row(v, vsc, vsh, lane);
        store_row_bf16(v, HN + (size_t)row * D, lane);
        float lg[16];
#pragma unroll
        for (int e = 0; e < 16; ++e) lg[e] = 0.f;
#pragma unroll
        for (int j = 0; j < 4; ++j)
#pragma unroll
            for (int e = 0; e < 16; ++e) { const f32x4 w = *(const LAS f32x4*)(rw + e * D + 4 * lane + 256 * j); const f32x4 x = v[j];
                lg[e] += (x.x * w.x + x.y * w.y) + (x.z * w.z + x.w * w.w); }
#pragma unroll
        for (int e = 0; e < 16; ++e) lg[e] = wave_sum(lg[e]);
        float aff[16], sel[16];
#pragma unroll
        for (int e = 0; e < 16; ++e) { aff[e] = 1.0f / (1.0f + expf(-lg[e])); sel[e] = aff[e] + a.in[I_RB][e]; }
        int grp = 0; float best = -1e30f;
#pragma unroll
        for (int g = 0; g < 4; ++g) { const float s0 = sel[4 * g], s1 = sel[4 * g + 1], s2 = sel[4 * g + 2], s3 = sel[4 * g + 3];
            const float tot = s0 + s1 + s2 + s3, mn1 = fminf(fminf(s0, s1), fminf(s2, s3));
            float m2 = fmaxf(fmaxf(fmaxf(s0 + s1, s0 + s2), fmaxf(s0 + s3, s1 + s2)), fmaxf(s1 + s3, s2 + s3)); (void)tot; (void)mn1;
            if (m2 > best) { best = m2; grp = g; } }
        float sg[4], ag[4];
#pragma unroll
        for (int j = 0; j < 4; ++j) { sg[j] = 0.f; ag[j] = 0.f; }
#pragma unroll
        for (int g = 0; g < 4; ++g) if (g == grp) {
#pragma unroll
            for (int j = 0; j < 4; ++j) { sg[j] = sel[4 * g + j]; ag[j] = aff[4 * g + j]; } }
        int i0 = 0; float b0 = sg[0];
#pragma unroll
        for (int j = 1; j < 4; ++j) if (sg[j] > b0) { b0 = sg[j]; i0 = j; }
        int i1 = 0; float b1 = -1e30f;
#pragma unroll
        for (int j = 0; j < 4; ++j) if (j != i0 && sg[j] > b1) { b1 = sg[j]; i1 = j; }
        float a0 = 0.f, a1 = 0.f;
#pragma unroll
        for (int j = 0; j < 4; ++j) { if (j == i0) a0 = ag[j]; if (j == i1) a1 = ag[j]; }
        const float inv = 1.0f / (a0 + a1);
        if (lane == 0) { ent[2 * lr] = grp * 4 + i0; ent[2 * lr + 1] = grp * 4 + i1; gts[2 * lr] = a0 * inv; gts[2 * lr + 1] = a1 * inv; }
    }
    __syncthreads();
    if (tid < 16) { int c = 0; for (int i = 0; i < 128; ++i) if (ent[i] == tid) lrank[i] = c++;
        ((unsigned*)(ws + WS_HIST))[(size_t)vcu * 16 + tid] = (unsigned)c; }
    __syncthreads();
}
__device__ __forceinline__ void router_finish(const Args& a, LAS unsigned char* lds, int layer, int vcu, int G) {
    const int tid = threadIdx.x; unsigned char* ws = a.ws;
    LAS int* ent = (LAS int*)(lds + 65536 + 8192); LAS int* lrank = ent + 128; LAS int* lbase = lrank + 128; LAS float* gts = (LAS float*)(lbase + 16);
    const int row0 = vcu * 64;
    LAS unsigned* hl = (LAS unsigned*)lds;
    for (int i = tid; i < G * 4; i += NTHR) *(LAS u32x4*)(hl + 4 * i) = *(const GAS u32x4*)((const unsigned*)(ws + WS_HIST) + 4 * i);
    __syncthreads();
    if (tid < 16) { unsigned base = 0u, tot = 0u;
        for (int b = 0; b < G; ++b) { const unsigned c = hl[b * 16 + tid]; tot += c; if (b < vcu) base += c; }
        lbase[tid] = (int)base;
        if (vcu == 0) __hip_atomic_store((unsigned*)(ws + WS_CTL) + CW_CNT + layer * 1024 + tid * 64, tot, __ATOMIC_RELAXED, __HIP_MEMORY_SCOPE_AGENT); }
    __syncthreads();
    if (tid < 128) { const int e = ent[tid], r = lbase[e] + lrank[tid], tok = row0 + (tid >> 1);
        ((unsigned*)(ws + WS_LIST))[(size_t)e * M + r] = (unsigned)tok;
        ((unsigned*)(ws + WS_TOKINFO))[(size_t)tok * 2 + (tid & 1)] = (unsigned)e | ((unsigned)r << 8);
        ((float*)(ws + WS_TOKINFO + 131072))[(size_t)tok * 2 + (tid & 1)] = gts[tid]; }
    __syncthreads();
}
__device__ __forceinline__ void moe_tables(const Args& a, volatile LAS int* tab, int layer, int ncol) {
    if (threadIdx.x < 64) {
        const int lane = threadIdx.x; const unsigned* cnt = (const unsigned*)(a.ws + WS_CTL) + CW_CNT + layer * 1024;
        const int c = lane < 16 ? (int)__hip_atomic_load(cnt + lane * 64, __ATOMIC_RELAXED, __HIP_MEMORY_SCOPE_AGENT) : 0;
        const int tiles = (c + 255) >> 8; int incl = tiles;
#pragma unroll
        for (int o = 1; o < 16; o <<= 1) { const int u = __shfl_up(incl, o); if (lane >= o) incl += u; }
        const int tp = incl - tiles;
        if (lane < 16) { tab[lane] = tp * ncol; tab[17 + lane] = tiles > 0 ? tiles : 1; tab[33 + lane] = tp * 256; tab[49 + lane] = c; }
        if (lane == 15) { tab[16] = incl * ncol; tab[65] = incl * ncol; }
    }
    __syncthreads();
}
__device__ __forceinline__ void combine_phase(const Args& a, LAS unsigned char* lds, int layer, const float* hin, float* hout, bool do_moe, bool final_, int vcu) {
    const int tid = threadIdx.x, lane = tid & 63, wid = __builtin_amdgcn_readfirstlane(tid >> 6);
    unsigned char* ws = a.ws;
    LAS float* vsc = (LAS float*)lds; LAS float* vsh = vsc + D; LAS float* g2 = vsh + D; LAS int* hr0 = (LAS int*)(g2 + D);
    const int row0 = vcu * 64, b = row0 / SEQ;
    if (final_) { for (int d = tid; d < D; d += NTHR) { vsc[d] = a.in[I_FG][d]; vsh[d] = 0.f; } }
    else load_norm_vecs(a, false, layer + 1, b, 0, a.in[I_N1G] + (layer + 1) * D, vsc, vsh);
    for (int d = tid; d < D; d += NTHR) g2[d] = mod_val(a, false, layer, b, 5 * 1024 + d);
    LAS int* ust = hr0 + 16; LAS int* tl = ust + 16; LAS int* nwgp = tl + 16;
    if (tid < 64) { const unsigned* cnt = (const unsigned*)(ws + WS_CTL) + CW_CNT + layer * 1024;
        const int c = tid < 16 ? (int)__hip_atomic_load(cnt + tid * 64, __ATOMIC_RELAXED, __HIP_MEMORY_SCOPE_AGENT) : 0;
        const int tiles = (c + 255) >> 8; int incl = tiles;
#pragma unroll
        for (int o = 1; o < 16; o <<= 1) { const int u = __shfl_up(incl, o); if (tid >= o) incl += u; }
        const int tp = incl - tiles;
        if (tid < 16) { hr0[tid] = tp * 256; ust[tid] = tp * (D / 256); tl[tid] = tiles > 0 ? tiles : 1; }
        if (tid == 15) nwgp[0] = incl * (D / 256); }
    __syncthreads();
    const bf16* Y = (const bf16*)(ws + WS_YSLOT); const bf16* SLB = (const bf16*)(ws + WS_SLAB);
    const int nwg_d = nwgp[0]; const bool split = (gridDim.x == 256) && nwg_d > 512 && nwg_d - 512 <= 64;
    u32x2 tiv[8]; f32x2 gwv[8];
#pragma unroll
    for (int i = 0; i < 8; ++i) { const int row = row0 + wid * 8 + i; tiv[i] = (u32x2){0u, 0u}; gwv[i] = (f32x2){0.f, 0.f};
        if (do_moe) { tiv[i] = *(const GAS u32x2*)((const unsigned*)(ws + WS_TOKINFO) + (size_t)row * 2); gwv[i] = *(const GAS f32x2*)((const float*)(ws + WS_TOKINFO + 131072) + (size_t)row * 2); } }
#pragma unroll
    for (int i = 0; i < 8; ++i) {
        const int row = row0 + wid * 8 + i;
        f32x4 v[4]; const GAS f32x4* xr = (const GAS f32x4*)(hin + (size_t)row * D) + lane;
#pragma unroll
        for (int j = 0; j < 4; ++j) v[j] = xr[64 * j];
        if (do_moe) {
            const u32x2 ti = tiv[i];
            const f32x2 gw = gwv[i];
            const int e0 = (int)(ti.x & 255u), r0 = (int)(ti.x >> 8), e1 = (int)(ti.y & 255u), r1 = (int)(ti.y >> 8);
            const int s0 = hr0[e0] + r0, s1 = hr0[e1] + r1;
            const float w0 = gw.x, w1 = gw.y;
            const GAS u32x2* y0 = (const GAS u32x2*)(Y + (size_t)s0 * D) + lane; const GAS u32x2* y1 = (const GAS u32x2*)(Y + (size_t)s1 * D) + lane;
            u32x2 yv0[4], yv1[4];
#pragma unroll
            for (int j = 0; j < 4; ++j) { yv0[j] = y0[64 * j]; yv1[j] = y1[64 * j]; }
#pragma unroll
            for (int j = 0; j < 4; ++j) { const f32x4 gg = *(const LAS f32x4*)(g2 + 4 * lane + 256 * j);
                f32x4 a0 = {bflo(yv0[j].x), bfhi(yv0[j].x), bflo(yv0[j].y), bfhi(yv0[j].y)}, a1 = {bflo(yv1[j].x), bfhi(yv1[j].x), bflo(yv1[j].y), bfhi(yv1[j].y)};
                const int wg0 = ust[e0] + j * tl[e0] + (r0 >> 8), wg1 = ust[e1] + j * tl[e1] + (r1 >> 8);
                if (split && wg0 >= 512) { const GAS u32x2* sp = (const GAS u32x2*)(SLB + (size_t)(wg0 - 512) * 4 * 65536 + (size_t)(r0 & 255) * 256) + lane; a0 = (f32x4){0.f, 0.f, 0.f, 0.f};
#pragma unroll
                    for (int q = 0; q < 4; ++q) { const u32x2 w = sp[q * 16384]; a0 = a0 + (f32x4){bflo(w.x), bfhi(w.x), bflo(w.y), bfhi(w.y)}; } }
                if (split && wg1 >= 512) { const GAS u32x2* sp = (const GAS u32x2*)(SLB + (size_t)(wg1 - 512) * 4 * 65536 + (size_t)(r1 & 255) * 256) + lane; a1 = (f32x4){0.f, 0.f, 0.f, 0.f};
#pragma unroll
                    for (int q = 0; q < 4; ++q) { const u32x2 w = sp[q * 16384]; a1 = a1 + (f32x4){bflo(w.x), bfhi(w.x), bflo(w.y), bfhi(w.y)}; } }
                v[j] = v[j] + gg * (a0 * w0 + a1 * w1); }
        }
        if (!final_) { GAS f32x4* o = (GAS f32x4*)(hout + (size_t)row * D) + lane;
#pragma unroll
            for (int j = 0; j < 4; ++j) o[64 * j] = v[j]; }
        rms_mod_row(v, vsc, vsh, lane);
        if (final_) { GAS f32x4* o = (GAS f32x4*)(a.out + (size_t)row * D) + lane;
            if (__hip_atomic_load((const unsigned*)(ws + WS_CTL) + CW_BAR + XB_TMO, __ATOMIC_RELAXED, __HIP_MEMORY_SCOPE_AGENT) != 0u) {
#pragma unroll
                for (int j = 0; j < 4; ++j) v[j] = v[j] + 1000.0f; }
#pragma unroll
            for (int j = 0; j < 4; ++j) o[64 * j] = v[j]; }
        else store_row_bf16(v, (bf16*)(ws + WS_HN) + (size_t)row * D, lane);
    }
    __syncthreads();
}


template <int KD, int ND, bool INF32>
__device__ __forceinline__ void headgemm(const void* in, int rs, int hs, const bf16* W, int wns, int whs, bf16* out, int ors, int ohs, float scale, int gw, int NGW, int lane) {
    const int fr = lane & 15, fq = lane >> 4;
    constexpr int KS = KD / 32, NT = ND / 16;
    const int h = gw & 15;
    bf16x8 Xf[NT][KS];
#pragma unroll
    for (int nt = 0; nt < NT; ++nt)
#pragma unroll
        for (int ks = 0; ks < KS; ++ks) Xf[nt][ks] = *(const GAS bf16x8*)(W + (size_t)(32 * (nt >> 1) + 8 * (fr >> 2) + 4 * (nt & 1) + (fr & 3)) * wns + h * whs + 32 * ks + 8 * fq);
    constexpr int NR = INF32 ? 2 * KS : KS;
    auto loadY = [&](int item, u32x4 (&R)[NR]) __attribute__((always_inline)) {
        const int t0 = (item >> 4) * 16;
#pragma unroll
        for (int ks = 0; ks < KS; ++ks) {
            if (INF32) { const float* p = (const float*)in + (size_t)(t0 + fr) * rs + h * hs + 32 * ks + 8 * fq; R[2 * ks] = *(const GAS u32x4*)p; R[2 * ks + 1] = *(const GAS u32x4*)(p + 4); }
            else R[ks] = *(const GAS u32x4*)((const bf16*)in + (size_t)(t0 + fr) * rs + h * hs + 32 * ks + 8 * fq);
        }
    };
    auto compute = [&](int item, const u32x4 (&R)[NR]) __attribute__((always_inline)) {
        const int t0 = (item >> 4) * 16;
        bf16x8 Y[KS];
#pragma unroll
        for (int ks = 0; ks < KS; ++ks) {
            if (INF32) { const f32x4 x0 = __builtin_bit_cast(f32x4, R[2 * ks]), x1 = __builtin_bit_cast(f32x4, R[2 * ks + 1]);
                const u32x4 w = {cvt_pk_bf16(x0[0], x0[1]), cvt_pk_bf16(x0[2], x0[3]), cvt_pk_bf16(x1[0], x1[1]), cvt_pk_bf16(x1[2], x1[3])}; Y[ks] = __builtin_bit_cast(bf16x8, w); }
            else Y[ks] = __builtin_bit_cast(bf16x8, R[ks]);
        }
#pragma unroll
        for (int nt = 0; nt < NT; nt += 2) {
            f32x4 acc = {0.f, 0.f, 0.f, 0.f}, acc2 = {0.f, 0.f, 0.f, 0.f};
#pragma unroll
            for (int ks = 0; ks < KS; ++ks) { acc = __builtin_amdgcn_mfma_f32_16x16x32_bf16(Xf[nt][ks], Y[ks], acc, 0, 0, 0); acc2 = __builtin_amdgcn_mfma_f32_16x16x32_bf16(Xf[nt + 1][ks], Y[ks], acc2, 0, 0, 0); }
            *(GAS u32x4*)(out + (size_t)(t0 + fr) * ors + h * ohs + 16 * nt + 8 * fq) = (u32x4){cvt_pk_bf16(acc[0] * scale, acc[1] * scale), cvt_pk_bf16(acc[2] * scale, acc[3] * scale), cvt_pk_bf16(acc2[0] * scale, acc2[1] * scale), cvt_pk_bf16(acc2[2] * scale, acc2[3] * scale)};
        }
    };
    const int total = (M / 16) * NH, n = gw < total ? (total - gw + NGW - 1) / NGW : 0;
    u32x4 RA[NR], RB[NR];
    int k = 0;
    if (n > 0) loadY(gw, RA);
    __builtin_amdgcn_sched_barrier(0);
#pragma unroll 1
    while (k + 2 < n) {
        loadY(gw + (k + 1) * NGW, RB);
        __builtin_amdgcn_sched_barrier(0);
        compute(gw + k * NGW, RA);
        __builtin_amdgcn_sched_barrier(0);
        loadY(gw + (k + 2) * NGW, RA);
        __builtin_amdgcn_sched_barrier(0);
        compute(gw + (k + 1) * NGW, RB);
        __builtin_amdgcn_sched_barrier(0);
        k += 2;
    }
    if (n - k == 2) { loadY(gw + (k + 1) * NGW, RB); __builtin_amdgcn_sched_barrier(0); compute(gw + k * NGW, RA); __builtin_amdgcn_sched_barrier(0); compute(gw + (k + 1) * NGW, RB); }
    else if (n - k == 1) compute(gw + k * NGW, RA);
}
__device__ __forceinline__ void post_phase(const Args& a, int gw, int NGW, int lane) {
    unsigned char* ws = a.ws;
    const float* P = (const float*)(ws + WS_PROJ);
    f32x4 cv[8], qa[8], qb[8]; float kk[8], ww[8];
#pragma unroll
    for (int i = 0; i < 8; ++i) { const float* pr = P + (size_t)(gw + i * NGW) * NPROJ;
        cv[i] = *(const GAS f32x4*)(pr + O_CKV + 4 * lane); qa[i] = *(const GAS f32x4*)(pr + O_QI + 8 * lane); qb[i] = *(const GAS f32x4*)(pr + O_QI + 8 * lane + 4);
        kk[i] = pr[O_KI + lane]; ww[i] = pr[O_WI + (lane & (HI - 1))]; }
    const f32x4 g = *(const GAS f32x4*)(a.in[I_BKVG] + 4 * lane); const float kg = a.in[I_BKIG][lane];
#pragma unroll
    for (int i = 0; i < 8; ++i) { const int row = gw + i * NGW; const f32x4 c = cv[i];
        const float r1 = 1.0f / sqrtf(wave_sum((c.x * c.x + c.y * c.y) + (c.z * c.z + c.w * c.w)) * (1.0f / CL) + EPS);
        *(GAS u32x2*)((bf16*)(ws + WS_CKV) + (size_t)row * CL + 4 * lane) = (u32x2){cvt_pk_bf16(c.x * r1 * g.x, c.y * r1 * g.y), cvt_pk_bf16(c.z * r1 * g.z, c.w * r1 * g.w)};
        const f32x4 q0 = qa[i], q1 = qb[i];
        *(GAS u32x4*)((bf16*)(ws + WS_QI) + (size_t)row * 512 + 8 * lane) = (u32x4){cvt_pk_bf16(q0.x, q0.y), cvt_pk_bf16(q0.z, q0.w), cvt_pk_bf16(q1.x, q1.y), cvt_pk_bf16(q1.z, q1.w)};
        const float k = kk[i];
        const float r2 = 1.0f / sqrtf(wave_sum(k * k) * (1.0f / DI) + EPS);
        ((bf16*)(ws + WS_KI))[(size_t)row * DI + lane] = (bf16)f2bf(k * r2 * kg);
        if (lane < HI) ((float*)(ws + WS_WI))[(size_t)row * HI + lane] = ww[i] * 0.04419417382415922f;
    }
    headgemm<HD, CL, true>(P, NPROJ, HD, (const bf16*)(ws + WS_WUK), NH * HD, HD, (bf16*)(ws + WS_QABS), NH * CL, CL, 0.125f, gw, NGW, lane);
}
__device__ __forceinline__ void indexer_phase(const Args& a, int G, int vcu) {
    const int tid = threadIdx.x, lane = tid & 63, wid = __builtin_amdgcn_readfirstlane(tid >> 6), fr = lane & 15, fq = lane >> 4;
    unsigned char* ws = a.ws;
    const bf16* QI = (const bf16*)(ws + WS_QI); const bf16* KI = (const bf16*)(ws + WS_KI); const float* WI = (const float*)(ws + WS_WI); float* SC = (float*)(ws + WS_SC);
    for (int u = vcu; u < NB_ * 528; u += G) {
        const int b = u / 528, r = u % 528;
        int tb = (int)((sqrtf(8.f * r + 1.f) - 1.f) * 0.5f); while ((tb + 1) * (tb + 2) / 2 <= r) ++tb; while (tb * (tb + 1) / 2 > r) --tb;
        const int sb = r - tb * (tb + 1) / 2;
        const int trow = b * SEQ + tb * 128 + 16 * wid + fr, srow0 = b * SEQ + sb * 128;
        bf16x8 Kf[8][2];
#pragma unroll
        for (int n = 0; n < 8; ++n)
#pragma unroll
            for (int ks = 0; ks < 2; ++ks) Kf[n][ks] = *(const GAS bf16x8*)(KI + (size_t)(srow0 + 16 * n + fr) * DI + 32 * ks + 8 * fq);
        f32x4 sc[8];
#pragma unroll
        for (int n = 0; n < 8; ++n) sc[n] = (f32x4){0.f, 0.f, 0.f, 0.f};
        const bf16* qrow = QI + (size_t)trow * 512 + 8 * fq;
        const f32x4 wq0 = *(const GAS f32x4*)(WI + (size_t)trow * HI), wq1 = *(const GAS f32x4*)(WI + (size_t)trow * HI + 4);
        bf16x8 QA0 = *(const GAS bf16x8*)(qrow), QA1 = *(const GAS bf16x8*)(qrow + 32), QB0, QB1;
#define IDX_HEAD(q0_, q1_, w_) do { _Pragma("unroll") for (int n = 0; n < 8; ++n) { f32x4 acc = {0.f, 0.f, 0.f, 0.f}; \
            acc = __builtin_amdgcn_mfma_f32_16x16x32_bf16(Kf[n][0], q0_, acc, 0, 0, 0); acc = __builtin_amdgcn_mfma_f32_16x16x32_bf16(Kf[n][1], q1_, acc, 0, 0, 0); \
            _Pragma("unroll") for (int j = 0; j < 4; ++j) sc[n][j] += (w_) * __builtin_amdgcn_fmed3f(acc[j], 0.f, 3.0e38f); } } while (0)
#pragma unroll 1
        for (int hp = 0; hp < 4; ++hp) {
            const f32x4 wv = hp < 2 ? wq0 : wq1; const float wa = (hp & 1) ? wv.z : wv.x, wb = (hp & 1) ? wv.w : wv.y;
            QB0 = *(const GAS bf16x8*)(qrow + (2 * hp + 1) * 64); QB1 = *(const GAS bf16x8*)(qrow + (2 * hp + 1) * 64 + 32);
            __builtin_amdgcn_sched_barrier(0);
            IDX_HEAD(QA0, QA1, wa);
            __builtin_amdgcn_sched_barrier(0);
            if (hp < 3) { QA0 = *(const GAS bf16x8*)(qrow + (2 * hp + 2) * 64); QA1 = *(const GAS bf16x8*)(qrow + (2 * hp + 2) * 64 + 32); }
            __builtin_amdgcn_sched_barrier(0);
            IDX_HEAD(QB0, QB1, wb);
            __builtin_amdgcn_sched_barrier(0);
        }
#undef IDX_HEAD
#pragma unroll
        for (int n = 0; n < 8; ++n) *(GAS f32x4*)(SC + (size_t)trow * SEQ + sb * 128 + 16 * n + 4 * fq) = sc[n];
    }
}
__device__ __forceinline__ void topk_phase(const Args& a, LAS unsigned char* lds, int gw, int NGW, int wave, int lane) {
    LAS unsigned* hist = (LAS unsigned*)(lds + wave * 17408);
    LAS unsigned* cand = hist + 256;
    const float* SC = (const float*)(a.ws + WS_SC); int* SEL = (int*)(a.ws + WS_SEL);
    const unsigned long long lt = (1ull << lane) - 1ull;
    for (int ri = 0; ri < M / NGW; ++ri) {
        const int rr = gw + ri * NGW, bb = rr / SEQ, tt = rr % SEQ;
        const int t = (tt >= SEQ / 2) ? (3 * SEQ / 2 - 1 - tt) : tt, row = bb * SEQ + t, n = t + 1;
        int* sel = SEL + (size_t)row * KTOP;
        if (n <= KTOP) { for (int j = lane; j < KTOP; j += 64) sel[j] = j < n ? j : 0; continue; }
        const float* sc = SC + (size_t)row * SEQ;
        float v[64]; float mn = 3.0e38f, mx = -3.0e38f;
#pragma unroll
        for (int g = 0; g < 4; ++g) if (g * 1024 < n) {
#pragma unroll
            for (int jj = 0; jj < 16; ++jj) { const int j = g * 16 + jj, s2 = j * 64 + lane; v[j] = sc[s2]; } }
        else {
#pragma unroll
            for (int jj = 0; jj < 16; ++jj) v[g * 16 + jj] = 0.f; }
        __builtin_amdgcn_sched_barrier(0);
#pragma unroll
        for (int g = 0; g < 4; ++g) if (g * 1024 < n) {
#pragma unroll
            for (int jj = 0; jj < 16; ++jj) { const int j = g * 16 + jj, s2 = j * 64 + lane; const float xr = v[j]; const bool ok = s2 < n;
                mn = fminf(mn, ok ? xr : 3.0e38f); mx = fmaxf(mx, ok ? xr : -3.0e38f); v[j] = ok ? xr : 0.f; } }
#pragma unroll
        for (int o = 1; o < 64; o <<= 1) { mn = fminf(mn, __shfl_xor(mn, o)); mx = fmaxf(mx, __shfl_xor(mx, o)); }
        const float range = mx - mn, scale = range > 0.f ? 16777215.0f / range : 0.f;
        *(LAS u32x4*)(hist + 4 * lane) = (u32x4){0u, 0u, 0u, 0u};
        LDS_WAIT();
#pragma unroll
        for (int g = 0; g < 4; ++g) if (g * 1024 < n) {
#pragma unroll
            for (int jj = 0; jj < 16; ++jj) { const int j = g * 16 + jj, s2 = j * 64 + lane; unsigned k = (unsigned)((v[j] - mn) * scale); k = k > 0xFFFFFFu ? 0xFFFFFFu : k;
                v[j] = __builtin_bit_cast(float, k);
                if (s2 < n) __hip_atomic_fetch_add(hist + (k >> 16), 1u, __ATOMIC_RELAXED, __HIP_MEMORY_SCOPE_WORKGROUP); } }
        LDS_WAIT();
        const u32x4 h4 = *(LAS u32x4*)(hist + 4 * lane);
        const unsigned tot = h4.x + h4.y + h4.z + h4.w;
        unsigned suf = tot;
#pragma unroll
        for (int o = 1; o < 64; o <<= 1) { const unsigned u = __shfl_down(suf, o); if (lane + o < 64) suf += u; }
        const unsigned above = suf - tot, kr = (unsigned)KTOP;
        const bool here = (above < kr) && (suf >= kr);
        const unsigned long long bm = __ballot(here); const int L = bm ? (__ffsll((long long)bm) - 1) : 0;
        const unsigned c3 = above + h4.w, c2 = c3 + h4.z, c1 = c2 + h4.y;
        int binl; unsigned ab;
        if (c3 >= kr) { binl = 3; ab = above; } else if (c2 >= kr) { binl = 2; ab = c3; } else if (c1 >= kr) { binl = 1; ab = c2; } else { binl = 0; ab = c1; }
        const unsigned b0 = (unsigned)__shfl(4 * lane + binl, L); const int abv = (int)__shfl(ab, L); const int krem = KTOP - abv;
        int pos = 0, ccnt = 0;
#pragma unroll
        for (int g = 0; g < 4; ++g) if (g * 1024 < n) {
#pragma unroll
            for (int jj = 0; jj < 16; ++jj) { const int j = g * 16 + jj, s2 = j * 64 + lane; const unsigned k = __builtin_bit_cast(unsigned, v[j]); const unsigned d = k >> 16; const bool valid = s2 < n;
                const bool gt = valid && d > b0, eq = valid && d == b0;
                const unsigned long long gm = __ballot(gt), em = __ballot(eq);
                if (gt) sel[pos + __popcll(gm & lt)] = s2;
                if (eq) cand[ccnt + __popcll(em & lt)] = ((k & 0xFFFFu) << 12) | (unsigned)(4095 - s2);
                pos += __popcll(gm); ccnt += __popcll(em); } }
        LDS_WAIT();
        for (int i0 = 0; i0 < ccnt; i0 += 64) { const int i = i0 + lane; const unsigned mine = i < ccnt ? cand[i] : 0xFFFFFFFFu; int rank = 0;
            for (int q = 0; q < ccnt; ++q) rank += (cand[q] > mine) ? 1 : 0;
            if (i < ccnt && rank < krem) sel[abv + rank] = 4095 - (int)(mine & 4095u); }
        LDS_WAIT();
    }
}
__device__ const unsigned char T5_BUCKET[128] = {0,1,2,3,4,5,6,7,8,9,10,11,12,13,14,15,16,16,16,17,17,18,18,18,19,19,19,20,20,20,20,21,21,21,21,22,22,22,22,22,23,23,23,23,23,23,24,24,24,24,24,24,25,25,25,25,25,25,25,26,26,26,26,26,26,26,26,27,27,27,27,27,27,27,27,27,27,28,28,28,28,28,28,28,28,28,28,29,29,29,29,29,29,29,29,29,29,29,29,30,30,30,30,30,30,30,30,30,30,30,30,30,30,31,31,31,31,31,31,31,31,31,31,31,31,31,31,31};
constexpr int ATT_STG = 147456;
constexpr int ATT_PAIR = 1040, ATT_BUF = 8 * ATT_PAIR, ATT_TABO = NWAVES * 2 * ATT_BUF;
__device__ __forceinline__ void attn_phase(const Args& a, LAS unsigned char* lds, int vcu, int G, int wave, int lane) {
    const int tid = threadIdx.x, fr = lane & 15, fq = lane >> 4, q4 = fr >> 2, p4 = fr & 3;
    unsigned char* ws = a.ws;
    LAS unsigned char* kvb = lds + wave * (2 * ATT_BUF);
    LAS float* rb = (LAS float*)(lds + ATT_TABO); LAS int* bkt = (LAS int*)(lds + ATT_TABO + 2048);
    for (int i = tid; i < 32 * NH; i += NTHR) rb[i] = a.in[I_RELB][i];
    if (tid < 128) bkt[tid] = T5_BUCKET[tid];
    __syncthreads();
    const bf16* QABS = (const bf16*)(ws + WS_QABS); const unsigned char* CKVB = (const unsigned char*)(ws + WS_CKV); const int* SEL = (const int*)(ws + WS_SEL); bf16* OLAT = (bf16*)(ws + WS_OLAT);
    const int bpb = G / NB_, b = vcu / bpb, lb = vcu % bpb, nbw = bpb * NWAVES;
    const int trrow = 4 * fq + q4, trbase = (trrow >> 1) * ATT_PAIR + (trrow & 1) * 512, trrot = (trrow & 1) ? 24 : 0;
    const int qbase = (fr >> 1) * ATT_PAIR + (fr & 1) * 512, qrot = (fr & 1) ? 24 : 0;
    LAS unsigned* kof = (LAS unsigned*)(lds + ATT_STG + wave * 2048); LAS int* bks = (LAS int*)(kof + 256);
    const int wpos = (lane >> 4) * 16 + (lane & 1) * 8 + ((lane & 15) >> 1);
    const unsigned lcx = (unsigned)((((lane & 31) + ((lane >> 5) << 3)) & 31) << 4);
    if (b < NB_)
    for (int t = lb * NWAVES + wave; t < SEQ; t += nbw) {
        const int row = b * SEQ + t, cnt = (t + 1 < KTOP) ? t + 1 : KTOP, nst = (cnt + 15) >> 4;
        bf16x8 Q[8];
#pragma unroll
        for (int ks = 0; ks < 8; ++ks) Q[ks] = *(const GAS bf16x8*)(QABS + ((size_t)row * NH + fr) * CL + 32 * ks + 8 * fq);
        const int* sel = SEL + (size_t)row * KTOP;
        const int sr0 = sel[lane], sr1 = sel[64 + lane], sr2 = sel[128 + lane], sr3 = sel[192 + lane];
        int br0, br1, br2, br3;
        { const int d0 = t - sr0, d1 = t - sr1, d2 = t - sr2, d3 = t - sr3;
          br0 = (d0 < 128 ? bkt[d0 < 0 ? 0 : d0] : 31) * NH; br1 = (d1 < 128 ? bkt[d1 < 0 ? 0 : d1] : 31) * NH; br2 = (d2 < 128 ? bkt[d2 < 0 ? 0 : d2] : 31) * NH; br3 = (d3 < 128 ? bkt[d3 < 0 ? 0 : d3] : 31) * NH; }
        const unsigned ko0 = (unsigned)(b * SEQ + sr0) * 512u, ko1 = (unsigned)(b * SEQ + sr1) * 512u, ko2 = (unsigned)(b * SEQ + sr2) * 512u, ko3 = (unsigned)(b * SEQ + sr3) * 512u;
        kof[wpos] = ko0; kof[64 + wpos] = ko1; kof[128 + wpos] = ko2; kof[192 + wpos] = ko3;
        bks[lane] = br0; bks[64 + lane] = br1; bks[128 + lane] = br2; bks[192 + lane] = br3;
        f32x4 o[16];
#pragma unroll
        for (int nt = 0; nt < 16; ++nt) o[nt] = (f32x4){0.f, 0.f, 0.f, 0.f};
        float mrun = -1e30f, lsum = 0.f;
        VM_WAIT();
#define ATT_DMA(st_) do { const int st__ = (st_); LAS unsigned char* dst_ = kvb + (st__ & 1) * ATT_BUF; \
        const u32x4 ka_ = *(const LAS u32x4*)(kof + st__ * 16 + (lane >> 5) * 8), kb_ = *(const LAS u32x4*)(kof + st__ * 16 + (lane >> 5) * 8 + 4); \
        const unsigned kk_[8] = {ka_.x, ka_.y, ka_.z, ka_.w, kb_.x, kb_.y, kb_.z, kb_.w}; \
        LDS_WAIT(); __builtin_amdgcn_sched_barrier(0); \
        _Pragma("unroll") for (int i_ = 0; i_ < 8; ++i_) \
            __builtin_amdgcn_global_load_lds((const unsigned*)(CKVB + (kk_[i_] + lcx)), (LAS unsigned*)(dst_ + i_ * ATT_PAIR), 16, 0, 0); } while (0)
        LDS_WAIT(); __builtin_amdgcn_sched_barrier(0);
        ATT_DMA(0);
        for (int st = 0; st < nst; ++st) {
            LAS unsigned char* kv = kvb + (st & 1) * ATT_BUF;
            const u32x4 b4_ = *(const LAS u32x4*)(bks + st * 16 + 4 * fq);
            const int bk4[4] = {(int)b4_.x, (int)b4_.y, (int)b4_.z, (int)b4_.w};
            LDS_WAIT(); __builtin_amdgcn_sched_barrier(0);
            if (st + 1 < nst) { ATT_DMA(st + 1); asm volatile("s_waitcnt vmcnt(8)" ::: "memory"); }
            else asm volatile("s_waitcnt vmcnt(0)" ::: "memory");
            __builtin_amdgcn_sched_barrier(0);
            f32x4 lg = {0.f, 0.f, 0.f, 0.f}, lg2 = {0.f, 0.f, 0.f, 0.f};
#pragma unroll
            for (int ks = 0; ks < 8; ks += 2) { const bf16x8 X = *(const LAS bf16x8*)(kv + qbase + (((4 * ks + fq + qrot) & 31) << 4)), X2 = *(const LAS bf16x8*)(kv + qbase + (((4 * (ks + 1) + fq + qrot) & 31) << 4));
                lg = __builtin_amdgcn_mfma_f32_16x16x32_bf16(X, Q[ks], lg, 0, 0, 0); lg2 = __builtin_amdgcn_mfma_f32_16x16x32_bf16(X2, Q[ks + 1], lg2, 0, 0, 0); }
            lg = lg + lg2;
            float x[4]; float mx = -1e30f;
#pragma unroll
            for (int j = 0; j < 4; ++j) { const int kidx = st * 16 + 4 * fq + j; float v = lg[j] + rb[bk4[j] + fr]; if (kidx >= cnt) v = -1e30f; x[j] = v; mx = fmaxf(mx, v); }
            { const auto s16 = __builtin_amdgcn_permlane16_swap(__builtin_bit_cast(unsigned, mx), __builtin_bit_cast(unsigned, mx), false, false);
              mx = fmaxf(__builtin_bit_cast(float, (unsigned)s16[0]), __builtin_bit_cast(float, (unsigned)s16[1]));
              const auto s32 = __builtin_amdgcn_permlane32_swap(__builtin_bit_cast(unsigned, mx), __builtin_bit_cast(unsigned, mx), false, false);
              mx = fmaxf(__builtin_bit_cast(float, (unsigned)s32[0]), __builtin_bit_cast(float, (unsigned)s32[1])); }
            const float mnew = fmaxf(mrun, mx);
            if (__any(mnew > mrun)) { const float alpha = fast_exp(mrun - mnew); lsum *= alpha;
#pragma unroll
                for (int nt = 0; nt < 16; ++nt) o[nt] = o[nt] * alpha; }
            mrun = mnew;
            float pv[4]; float ps = 0.f;
#pragma unroll
            for (int j = 0; j < 4; ++j) { pv[j] = fast_exp(x[j] - mnew); ps += pv[j]; }
            lsum += ps;
            const u32x2 pw = {cvt_pk_bf16(pv[0], pv[1]), cvt_pk_bf16(pv[2], pv[3])};
            const bf16x4 Pf = __builtin_bit_cast(bf16x4, pw);
            {
                const unsigned kva = (unsigned)(size_t)kv + (unsigned)trbase;
                bf16x4 XA[4], XB[4];
#define ATT_TR(dst_, g_) _Pragma("unroll") for (int nt = 0; nt < 4; ++nt) asm volatile("ds_read_b64_tr_b16 %0, %1" : "=v"(dst_[nt]) : "v"(kva + (unsigned)((((4 * ((nt + 4 * (g_)) >> 1) + p4 + trrot) & 31) << 4) + 8 * ((nt + 4 * (g_)) & 1))))
#define ATT_TW(x_) asm volatile("s_waitcnt lgkmcnt(0)" : "+v"(x_[0]), "+v"(x_[1]), "+v"(x_[2]), "+v"(x_[3]))
#define ATT_MM(x_, g_) _Pragma("unroll") for (int nt = 0; nt < 4; ++nt) o[nt + 4 * (g_)] = __builtin_amdgcn_mfma_f32_16x16x16bf16_1k(x_[nt], Pf, o[nt + 4 * (g_)], 0, 0, 0)
                ATT_TR(XA, 0); ATT_TW(XA); ATT_TR(XB, 1); ATT_MM(XA, 0); ATT_TW(XB); ATT_TR(XA, 2); ATT_MM(XB, 1); ATT_TW(XA); ATT_TR(XB, 3); ATT_MM(XA, 2); ATT_TW(XB); ATT_MM(XB, 3);
#undef ATT_TR
#undef ATT_TW
#undef ATT_MM
            }
        }
#undef ATT_DMA
        lsum += __shfl_xor(lsum, 16); lsum += __shfl_xor(lsum, 32);
        const float inv = 1.0f / lsum;
#pragma unroll
        for (int np = 0; np < 8; ++np) *(GAS u32x4*)(OLAT + ((size_t)row * NH + fr) * CL + 32 * np + 8 * fq) = (u32x4){cvt_pk_bf16(o[2 * np][0] * inv, o[2 * np][1] * inv), cvt_pk_bf16(o[2 * np][2] * inv, o[2 * np][3] * inv), cvt_pk_bf16(o[2 * np + 1][0] * inv, o[2 * np + 1][1] * inv), cvt_pk_bf16(o[2 * np + 1][2] * inv, o[2 * np + 1][3] * inv)};
        LDS_WAIT();
        { const int slot = (t - (lb * NWAVES + wave)) / nbw;
          const int gwv = (b * bpb + lb) * NWAVES + wave;
          const int NGWV = NB_ * bpb * NWAVES, total = 3 * 16 * 1792;
          cv64_batch3(a, (LAS float*)kvb, (slot * 3) * NGWV + gwv, NGWV, 1, lane); }
    }
    LDS_WAIT();
    __syncthreads();
}


constexpr int NPH = 20;
__global__ void __launch_bounds__(NTHR, 2) fwd(Args args) {
    extern __shared__ __attribute__((aligned(16))) unsigned char smem[];
    LAS unsigned char* lds = (LAS unsigned char*)smem;
    volatile LAS unsigned* MISC = (volatile LAS unsigned*)(lds + MISC_OFF);
    volatile LAS int* tab = (volatile LAS int*)(lds + MISC_OFF + 256);
    const int tid = threadIdx.x, lane = tid & 63, wave = __builtin_amdgcn_readfirstlane(tid >> 6);
    const int G = gridDim.x; const int bx = blockIdx.x; const int vcu = (G % 8 == 0) ? (bx % 8) * (G / 8) + bx / 8 : bx;
    const int gw = vcu * NWAVES + wave, NGW = G * NWAVES;
    unsigned char* ws = args.ws;
    if (tid < 64) MISC[tid] = 0u;
    __syncthreads();
    const int lo = args.ph_lo, hi = args.ph_hi;
    XcdBarrier bar; bar.bar = (unsigned*)(ws + WS_CTL) + CW_BAR; bar.x = 0; bar.st = nullptr;
    if (hi - lo > 1) bar = xcd_barrier_post((unsigned*)(ws + WS_CTL) + CW_BAR, MISC + 8);
#ifndef MK_MASK
#define MK_MASK 0xFFFFFu
#endif
#define IN(k) (((MK_MASK >> (k)) & 1u) && lo <= (k) && (k) < hi)
#ifndef MK_DBL
#define MK_DBL 0u
#endif
#define REP(k) for (int rep_ = 0; rep_ < (int)((MK_DBL >> (k)) & 1u) + 1; ++rep_)
#define SEAM(k) do { if (IN(k) && IN((k) + 1)) xcd_barrier(bar); } while (0)
    const float* X = args.in[I_X];
    float* HA = (float*)(ws + WS_HA); float* HB = (float*)(ws + WS_HB); bf16* HN = (bf16*)(ws + WS_HN);
    const float* MODF = (const float*)(ws + WS_MODF);

    if (IN(0)) REP(0) p0_prologue(args, lds, gw, NGW, wave, lane);
    SEAM(0);
    if (IN(1)) REP(1) {
        if (tid < 192) { const int idx = vcu * 192 + tid; if (idx < 49152) { float s = args.in[I_ADAB][(idx / 24576) * 6144 + idx % 6144]; const float* mp = (const float*)(ws + WS_MODP) + idx;
#pragma unroll
            for (int ks = 0; ks < 8; ++ks) s += mp[(size_t)ks * 49152];
            ((float*)(ws + WS_MODF))[idx] = s; } }
        LAS float* vsc = (LAS float*)lds; LAS float* vsh = vsc + D;
        const int row0 = vcu * 64, b = row0 / SEQ;
        load_norm_vecs(args, true, 0, b, 0, args.in[I_N1G], vsc, vsh);
        __syncthreads();
        f32x4 vv[8][4];
#pragma unroll
        for (int i = 0; i < 8; ++i) { const GAS f32x4* xr = (const GAS f32x4*)(X + (size_t)(row0 + wave * 8 + i) * D) + lane;
#pragma unroll
            for (int j = 0; j < 4; ++j) vv[i][j] = xr[64 * j]; }
#pragma unroll
        for (int i = 0; i < 8; ++i) { rms_mod_row(vv[i], vsc, vsh, lane); store_row_bf16(vv[i], HN + (size_t)(row0 + wave * 8 + i) * D, lane); }
        __syncthreads();
    }
    SEAM(1);
    if (IN(2)) REP(2) {
        pg8::DenseSched S; S.init(HN, (const bf16*)(ws + WS_WINA), M, NZ, D, G, bx);
        pg8::EpiGeluUV E{(bf16*)(ws + WS_U), (bf16*)(ws + WS_V), (f32x2*)(ws + WS_VSTAT)};
        pg8::gemm_phase(lds, S, E);
    }
    SEAM(2);
    if (IN(3)) REP(3) spatial_phase(args, lds, G, vcu);
    SEAM(3);
    if (IN(4)) REP(4) {
        pg8::DenseSched S; S.init((const bf16*)(ws + WS_S), (const bf16*)(ws + WS_WOUTA), M, D, AIN, G, bx);
        pg8::EpiResid E{X, HA, MODF + 0 * 24576 + 2 * 1024};
        pg8::gemm_phase(lds, S, E);
    }
    SEAM(4);
#if MK_STAGE >= 2
    if (IN(5)) REP(5) router_phase(args, lds, 0, HA, vcu);
    SEAM(5);
    if (IN(6)) REP(6) {
        router_finish(args, lds, 0, vcu, G); xcd_barrier(bar);
        moe_tables(args, tab, 0, NGU / 256);
        pg8::MoeSched S{HN, (const bf16*)(ws + WS_WGU), (const unsigned*)(ws + WS_LIST), tab, D, NGU / 256, G, bx, true, (size_t)NGU * D * 2, (LAS unsigned*)(lds + 132 * 1024), false};
        pg8::EpiSwiGLU E{(bf16*)(ws + WS_HMOE)};
        pg8::gemm_phase(lds, S, E);
    }
    SEAM(6);
    if (IN(7)) REP(7) {
        moe_tables(args, tab, 0, D / 256);
        pg8::MoeSched S{(const bf16*)(ws + WS_HMOE), (const bf16*)(ws + WS_WD), (const unsigned*)(ws + WS_LIST), tab, DE, D / 256, G, bx, false, (size_t)D * DE * 2, (LAS unsigned*)(lds + 132 * 1024), true};
        pg8::EpiYbf E{(bf16*)(ws + WS_YSLOT), (bf16*)(ws + WS_SLAB)};
        pg8::gemm_phase(lds, S, E);
    }
    SEAM(7);
    if (IN(8)) REP(8) combine_phase(args, lds, 0, HA, HB, true, false, vcu);
    SEAM(8);
#endif
#if MK_STAGE >= 3
    if (IN(9)) REP(9) {
        pg8::DenseSched S; S.init(HN, (const bf16*)(ws + WS_WINB), M, NPROJ, D, G, bx);
        pg8::EpiF32 E{(float*)(ws + WS_PROJ), NPROJ, nullptr};
        pg8::gemm_phase(lds, S, E);
    }
    SEAM(9);
    if (IN(10)) REP(10) post_phase(args, gw, NGW, lane);
    SEAM(10);
    if (IN(11)) REP(11) indexer_phase(args, G, vcu);
    SEAM(11);
    if (IN(12)) REP(12) topk_phase(args, lds, gw, NGW, wave, lane);
    SEAM(12);
    if (IN(13)) REP(13) attn_phase(args, lds, vcu, G, wave, lane);
    SEAM(13);
    if (IN(14)) REP(14) headgemm<CL, HD, false>((const void*)(ws + WS_OLAT), NH * CL, CL, (const bf16*)(ws + WS_WUVT), CL, HD * CL, (bf16*)(ws + WS_O), D, HD, 1.0f, gw, NGW, lane);
    SEAM(14);
    if (IN(15)) REP(15) {
        pg8::DenseSched S; S.init((const bf16*)(ws + WS_O), (const bf16*)(ws + WS_WOUTB), M, D, D, G, bx);
        pg8::EpiResid E{HB, HA, MODF + 1 * 24576 + 2 * 1024};
        pg8::gemm_phase(lds, S, E);
    }
    SEAM(15);
#endif
#if MK_STAGE >= 9
    if (IN(16)) REP(16) router_phase(args, lds, 1, HA, vcu);
    SEAM(16);
    if (IN(17)) REP(17) {
        router_finish(args, lds, 1, vcu, G); xcd_barrier(bar);
        moe_tables(args, tab, 1, NGU / 256);
        pg8::MoeSched S{HN, (const bf16*)(ws + WS_WGU) + (size_t)NE * NGU * D, (const unsigned*)(ws + WS_LIST), tab, D, NGU / 256, G, bx, true, (size_t)NGU * D * 2, (LAS unsigned*)(lds + 132 * 1024), false};
        pg8::EpiSwiGLU E{(bf16*)(ws + WS_HMOE)};
        pg8::gemm_phase(lds, S, E);
    }
    SEAM(17);
    if (IN(18)) REP(18) {
        moe_tables(args, tab, 1, D / 256);
        pg8::MoeSched S{(const bf16*)(ws + WS_HMOE), (const bf16*)(ws + WS_WD) + (size_t)NE * D * DE, (const unsigned*)(ws + WS_LIST), tab, DE, D / 256, G, bx, false, (size_t)D * DE * 2, (LAS unsigned*)(lds + 132 * 1024), true};
        pg8::EpiYbf E{(bf16*)(ws + WS_YSLOT), (bf16*)(ws + WS_SLAB)};
        pg8::gemm_phase(lds, S, E);
    }
    SEAM(18);
    if (IN(19)) REP(19) combine_phase(args, lds, 1, HA, nullptr, true, true, vcu);
#elif MK_STAGE >= 3
    if (IN(19)) REP(19) combine_phase(args, lds, 1, HA, nullptr, false, true, vcu);
#elif MK_STAGE >= 2
    if (IN(19)) REP(19) combine_phase(args, lds, 1, HB, nullptr, false, true, vcu);
#else
    if (IN(19)) REP(19) combine_phase(args, lds, 1, HA, nullptr, false, true, vcu);
#endif
#undef IN
#undef SEAM
}

extern "C" void kernel_launch(void* const* d_in, const int* in_sizes, int n_in, void* d_out, int out_size, void* d_ws, size_t ws_size, hipStream_t stream) {
    static int grid = 0;
    if (grid == 0) {
        if (n_in != 25 || in_sizes[0] != M * D || out_size != M * D || ws_size < WS_END) { fprintf(stderr, "kernel_launch: unexpected shapes / workspace (%d inputs, ws %zu < %zu)\n", n_in, ws_size, (size_t)WS_END); grid = -1; return; }
        int dev = 0, cus = 0, per_cu = 0;
        if (hipGetDevice(&dev) != hipSuccess || hipDeviceGetAttribute(&cus, hipDeviceAttributeMultiprocessorCount, dev) != hipSuccess) { grid = -1; return; }
        if (hipFuncSetAttribute((const void*)fwd, hipFuncAttributeMaxDynamicSharedMemorySize, LDS_BYTES) != hipSuccess) { fprintf(stderr, "kernel_launch: hipFuncSetAttribute failed\n"); grid = -1; return; }
        if (hipOccupancyMaxActiveBlocksPerMultiprocessor(&per_cu, (const void*)fwd, NTHR, LDS_BYTES) != hipSuccess || per_cu < 1) fprintf(stderr, "kernel_launch: occupancy query says %d\n", per_cu);
        (void)hipGetLastError();
        grid = cus;
    }
    if (grid < 0) return;
    if (hipMemsetAsync((char*)d_ws + WS_CTL, 0, CTL_ZERO_BYTES, stream) != hipSuccess) return;
    Args a{};
    for (int i = 0; i < 25; ++i) a.in[i] = (const float*)d_in[i];
    a.out = (float*)d_out; a.ws = (unsigned char*)d_ws;
    a.ph_lo = 0; a.ph_hi = NPH;
    hipLaunchKernelGGL(fwd, dim3(grid), dim3(NTHR), LDS_BYTES, stream, a);
}
```
